# Optimizing an MI355X kernel written in HIP

```python
import math
import jax, jax.numpy as jnp
from jax import lax
import numpy as np

D_MODEL = 1024
BATCH = 1
SEQ = 16384
DEPTH = 4

HEAD_DIM = 64
A_HEADS = 8
MOBA_BLOCK = 256
MOBA_TOPK = 3
MOBA_QCHUNK = 64
B_HEADS = 8
B_KV_HEADS = 2
B_WINDOW = 128
C_GROUPS = ((128, 1), (512, 4), (2048, 16))
N_C_GROUPS = 3
C_HEADS_PER_GROUP = 4
C_HEADS = N_C_GROUPS * C_HEADS_PER_GROUP
C_MAX_DILATION = 16
BAND = 128
D_FF = ((8 * D_MODEL + 3 * 256 - 1) // (3 * 256)) * 256
A_QKV = 3 * A_HEADS * HEAD_DIM
B_Q = B_HEADS * HEAD_DIM
B_KV = 2 * B_KV_HEADS * HEAD_DIM
C_QKV = 3 * C_HEADS * HEAD_DIM
N_BRANCH = 3
GATE_W = N_BRANCH * D_MODEL
IN_WIDTH = A_QKV + B_Q + B_KV + C_QKV + GATE_W
N_ALIBI_HEADS = A_HEADS + B_HEADS + C_HEADS
SEQ_MULTIPLE = math.lcm(BAND * C_MAX_DILATION, MOBA_BLOCK, MOBA_QCHUNK)
RMS_EPS = 1e-6

kernel_name = "hybrid_moba_swa_dilated_gated_trunk"


def alibi_slopes():
    n = N_ALIBI_HEADS
    s = 2.0 ** (-8.0 * (np.arange(n) + 1) / n)
    return jnp.asarray(s, dtype=jnp.float32)


def rmsnorm(x, g):
    xf = x.astype(jnp.float32)
    y = xf * lax.rsqrt(jnp.mean(xf * xf, axis=-1, keepdims=True) + RMS_EPS)
    return (y * g.astype(jnp.float32)).astype(x.dtype)


def banded_attention(q, k, v, slopes, max_steps, dilation, sinks=None):
    Bn, S, Hq, Dh = q.shape
    Hkv = k.shape[2]
    G = Hq // Hkv
    L = S // dilation
    nb = L // BAND

    def split(a):
        h = a.shape[2]
        a = a.reshape(Bn, L, dilation, h, Dh).transpose(0, 2, 1, 3, 4)
        return a.reshape(Bn, dilation, nb, BAND, h, Dh)

    def with_prev(a):
        prev = jnp.concatenate([jnp.zeros_like(a[:, :, :1]), a[:, :, :-1]], axis=2)
        return jnp.concatenate([prev, a], axis=3)

    qb = split(q).reshape(Bn, dilation, nb, BAND, Hkv, G, Dh)
    kk = with_prev(split(k))
    vv = with_prev(split(v))
    s = jnp.einsum('brnihgd,brnjhd->brnhgij', qb, kk).astype(jnp.float32) * (Dh ** -0.5)
    i = jnp.arange(BAND)[:, None]
    j = jnp.arange(2 * BAND)[None, :]
    steps = i + BAND - j
    blk = jnp.arange(nb)[:, None, None]
    mask = (steps >= 0) & (steps <= max_steps) & ((blk > 0) | (j >= BAND))
    bias = -slopes.reshape(Hkv, G)[:, :, None, None] * (steps * dilation).astype(jnp.float32)
    s = jnp.where(mask[:, None, None], s + bias, -jnp.inf)
    m = jnp.max(s, axis=-1)
    if sinks is not None:
        sink = sinks.reshape(Hkv, G, 1).astype(jnp.float32)
        m = jnp.maximum(m, sink)
    p = jnp.exp(s - m[..., None])
    denom = jnp.sum(p, axis=-1)
    if sinks is not None:
        denom = denom + jnp.exp(sink - m)
    o = jnp.einsum('brnhgij,brnjhd->brnihgd', p.astype(v.dtype), vv).astype(jnp.float32)
    denom_t = denom.transpose(0, 1, 2, 5, 3, 4)
    o = o / denom_t[..., None]
    lse = m.transpose(0, 1, 2, 5, 3, 4) + jnp.log(denom_t)
    o = o.reshape(Bn, dilation, L, Hq, Dh).transpose(0, 2, 1, 3, 4).reshape(Bn, S, Hq, Dh)
    lse = lse.reshape(Bn, dilation, L, Hq).transpose(0, 2, 1, 3).reshape(Bn, S, Hq)
    return o, lse


def moba_attention(q, k, v, slopes):
    Bn, S, H, Dh = q.shape
    nblk = S // MOBA_BLOCK
    ksel = min(MOBA_TOPK, nblk)
    nc = S // MOBA_QCHUNK
    scale = Dh ** -0.5
    kbh = k.transpose(0, 2, 1, 3).reshape(Bn, H, nblk, MOBA_BLOCK, Dh)
    vbh = v.transpose(0, 2, 1, 3).reshape(Bn, H, nblk, MOBA_BLOCK, Dh)
    kmean = jnp.mean(kbh.astype(jnp.float32), axis=3)
    gate = jnp.einsum('bshd,bhnd->bhsn', q.astype(jnp.float32), kmean)
    own = jnp.arange(S) // MOBA_BLOCK
    past = jnp.arange(nblk)[None, :] < own[:, None]
    gate = jnp.where(past, gate, -jnp.inf)
    _, sel = lax.top_k(gate, ksel)
    q_c = q.reshape(Bn, nc, MOBA_QCHUNK, H, Dh).transpose(1, 0, 3, 2, 4)
    sel_c = sel.reshape(Bn, H, nc, MOBA_QCHUNK, ksel).transpose(2, 0, 1, 3, 4)
    bi = jnp.arange(Bn)[:, None, None, None]
    hi = jnp.arange(H)[None, :, None, None]
    slope = slopes.astype(jnp.float32)[None, :, None, None]

    def chunk(args):
        ci, qc, sc = args
        t = ci * MOBA_QCHUNK + jnp.arange(MOBA_QCHUNK)
        own_blk = (ci * MOBA_QCHUNK) // MOBA_BLOCK
        k_sel = kbh[bi, hi, sc]
        v_sel = vbh[bi, hi, sc]
        k_own = lax.dynamic_index_in_dim(kbh, own_blk, axis=2, keepdims=False)
        v_own = lax.dynamic_index_in_dim(vbh, own_blk, axis=2, keepdims=False)
        pos_sel = sc[..., None] * MOBA_BLOCK + jnp.arange(MOBA_BLOCK)
        valid = (jnp.arange(ksel)[None, :] < (t // MOBA_BLOCK)[:, None])[None, None, :, :, None]
        s_sel = jnp.einsum('bhqd,bhqjkd->bhqjk', qc, k_sel).astype(jnp.float32) * scale
        s_sel = jnp.where(valid, s_sel - slope[..., None] * (t[:, None, None] - pos_sel).astype(jnp.float32), -jnp.inf)
        pos_own = own_blk * MOBA_BLOCK + jnp.arange(MOBA_BLOCK)
        d_own = t[:, None] - pos_own[None, :]
        s_own = jnp.einsum('bhqd,bhkd->bhqk', qc, k_own).astype(jnp.float32) * scale
        s_own = jnp.where(d_own >= 0, s_own - slope * d_own.astype(jnp.float32), -jnp.inf)
        s_all = jnp.concatenate([s_sel.reshape(Bn, H, MOBA_QCHUNK, ksel * MOBA_BLOCK), s_own], axis=-1)
        p = jax.nn.softmax(s_all, axis=-1).astype(v.dtype)
        p_sel = p[..., :ksel * MOBA_BLOCK].reshape(Bn, H, MOBA_QCHUNK, ksel, MOBA_BLOCK)
        p_own = p[..., ksel * MOBA_BLOCK:]
        return (jnp.einsum('bhqjk,bhqjkd->bhqd', p_sel, v_sel)
                + jnp.einsum('bhqk,bhkd->bhqd', p_own, v_own))

    o = lax.map(chunk, (jnp.arange(nc), q_c, sel_c))
    return o.transpose(1, 0, 3, 2, 4).reshape(Bn, S, H, Dh)


def dilated_attention(q, k, v, slopes):
    outs, lses = [], []
    for g, (w, d) in enumerate(C_GROUPS):
        o, lse = banded_attention(q[:, :, g], k[:, :, g], v[:, :, g],
                                  slopes[g * C_HEADS_PER_GROUP:(g + 1) * C_HEADS_PER_GROUP], w // d, d)
        outs.append(o)
        lses.append(lse)
    wts = jax.nn.softmax(jnp.stack(lses, axis=0), axis=0)
    return jnp.sum(wts[..., None] * jnp.stack(outs, axis=0), axis=0)


def token_mixers(u, w_in, sinks, w_br_a, w_br_b, w_br_c, w_out, slopes):
    Bn, S, _ = u.shape
    z = jnp.dot(u, w_in)
    o1 = A_QKV
    o2 = o1 + B_Q
    o3 = o2 + B_KV
    o4 = o3 + C_QKV
    za, zbq, zbkv, zc, zg = jnp.split(z, [o1, o2, o3, o4], axis=-1)
    slopes_b = slopes[:B_HEADS]
    slopes_c = slopes[B_HEADS:B_HEADS + C_HEADS]
    slopes_a = slopes[B_HEADS + C_HEADS:]
    za = za.reshape(Bn, S, 3, A_HEADS, HEAD_DIM)
    oa = moba_attention(za[:, :, 0], za[:, :, 1], za[:, :, 2], slopes_a).astype(u.dtype)
    ya = jnp.dot(oa.reshape(Bn, S, A_HEADS * HEAD_DIM), w_br_a)
    qb = zbq.reshape(Bn, S, B_HEADS, HEAD_DIM)
    zbkv = zbkv.reshape(Bn, S, 2, B_KV_HEADS, HEAD_DIM)
    ob, _ = banded_attention(qb, zbkv[:, :, 0], zbkv[:, :, 1], slopes_b, B_WINDOW - 1, 1, sinks)
    yb = jnp.dot(ob.astype(u.dtype).reshape(Bn, S, B_HEADS * HEAD_DIM), w_br_b)
    zc = zc.reshape(Bn, S, N_C_GROUPS, 3, C_HEADS_PER_GROUP, HEAD_DIM)
    oc = dilated_attention(zc[:, :, :, 0], zc[:, :, :, 1], zc[:, :, :, 2], slopes_c).astype(u.dtype)
    yc = jnp.dot(oc.reshape(Bn, S, C_HEADS_PER_GROUP * HEAD_DIM), w_br_c)
    gates = jax.nn.sigmoid(zg.astype(jnp.float32)).astype(u.dtype).reshape(Bn, S, N_BRANCH, D_MODEL)
    merged = gates[:, :, 0] * ya + gates[:, :, 1] * yb + gates[:, :, 2] * yc
    return jnp.dot(merged, w_out)


def swiglu(u, w_gate, w_up, w_down):
    return jnp.dot(jax.nn.silu(jnp.dot(u, w_gate)) * jnp.dot(u, w_up), w_down)


def setup_inputs(seed: int = 0) -> dict:
    key = jax.random.key(seed)
    ks = jax.random.split(key, 20)
    f32 = jnp.float32
    D = D_MODEL

    def nrm(k, shape, scale):
        return jax.random.normal(k, shape, f32) * scale

    return {
        "x": nrm(ks[0], (BATCH, SEQ, D), 1.0),
        "c": nrm(ks[1], (BATCH, D), 1.0),
        "w_ada": nrm(ks[2], (DEPTH, D, 6 * D), 0.5 * D ** -0.5),
        "b_ada": nrm(ks[3], (DEPTH, 6 * D), 0.01),
        "g_pre_mix": 1.0 + nrm(ks[4], (DEPTH, D), 0.05),
        "g_post_mix": 1.0 + nrm(ks[5], (DEPTH, D), 0.05),
        "w_in": nrm(ks[6], (DEPTH, D, IN_WIDTH), D ** -0.5),
        "sinks": nrm(ks[7], (DEPTH, B_HEADS), 1.0),
        "w_br_a": nrm(ks[8], (DEPTH, A_HEADS * HEAD_DIM, D), (A_HEADS * HEAD_DIM) ** -0.5),
        "w_br_b": nrm(ks[9], (DEPTH, B_HEADS * HEAD_DIM, D), (B_HEADS * HEAD_DIM) ** -0.5),
        "w_br_c": nrm(ks[10], (DEPTH, C_HEADS_PER_GROUP * HEAD_DIM, D), (C_HEADS_PER_GROUP * HEAD_DIM) ** -0.5),
        "w_out": nrm(ks[11], (DEPTH, D, D), D ** -0.5),
        "g_pre_ffn": 1.0 + nrm(ks[12], (DEPTH, D), 0.05),
        "g_post_ffn": 1.0 + nrm(ks[13], (DEPTH, D), 0.05),
        "w_gate": nrm(ks[14], (DEPTH, D, D_FF), D ** -0.5),
        "w_up": nrm(ks[15], (DEPTH, D, D_FF), D ** -0.5),
        "w_down": nrm(ks[16], (DEPTH, D_FF, D), D_FF ** -0.5),
    }


def reference(x, c, w_ada, b_ada, g_pre_mix, g_post_mix, w_in, sinks, w_br_a, w_br_b, w_br_c,
              w_out, g_pre_ffn, g_post_ffn, w_gate, w_up, w_down):
    Bn, S, _ = x.shape
    S_pad = -(-S // SEQ_MULTIPLE) * SEQ_MULTIPLE
    h = jnp.pad(x, ((0, 0), (0, S_pad - S), (0, 0)))
    slopes = alibi_slopes()
    for l in range(DEPTH):
        mod = jnp.dot(jax.nn.silu(c), w_ada[l]) + b_ada[l]
        sh1, sc1, gt1, sh2, sc2, gt2 = [m[:, None, :] for m in jnp.split(mod, 6, axis=-1)]
        u = rmsnorm(h, g_pre_mix[l]) * (1.0 + sc1) + sh1
        y = token_mixers(u, w_in[l], sinks[l], w_br_a[l], w_br_b[l], w_br_c[l], w_out[l], slopes)
        h = h + gt1 * rmsnorm(y, g_post_mix[l])
        u = rmsnorm(h, g_pre_ffn[l]) * (1.0 + sc2) + sh2
        y = swiglu(u, w_gate[l], w_up[l], w_down[l])
        h = h + gt2 * rmsnorm(y, g_post_ffn[l])
    return h[:, :S]
```

```cpp
#include <hip/hip_runtime.h>
#include <cstdio>
#include <cstdint>

#ifndef MK_MULTI
#define MK_MULTI 0
#endif

#define GAS __attribute__((address_space(1)))
#define LAS __attribute__((address_space(3)))
typedef unsigned short bf16_t;
typedef short bf16x8 __attribute__((ext_vector_type(8)));
typedef float f32x4 __attribute__((ext_vector_type(4)));
typedef float f32x2 __attribute__((ext_vector_type(2)));
typedef unsigned u32x4 __attribute__((ext_vector_type(4)));
typedef unsigned u32x2 __attribute__((ext_vector_type(2)));

constexpr int S = 16384, D = 1024, DEPTH = 4, HD = 64;
constexpr int NQKV = 4608, NGATE = 3072, NIN = 7680, DFF = 2816, NGU = 5632, KCAT = 1280;
constexpr int A_Q = 0, A_K = 512, A_V = 1024, B_Q = 1536, B_K = 2048, B_V = 2176, C_BASE = 2304;
constexpr float LOG2E = 1.4426950408889634f, QSCALE = 0.125f * LOG2E, RMS_EPS = 1e-6f;
constexpr int NWAVES = 8, NTHREADS = 512;

constexpr size_t MiB = 1u << 20;
constexpr size_t WS_CTL = 0, CTL_ZERO_BYTES = 64 * 1024;
constexpr size_t WS_CNT = 256 * 1024;
constexpr size_t WS_MOD = 512 * 1024;
constexpr size_t WS_KMEAN = 1 * MiB;
constexpr size_t WS_SEL = 1 * MiB + 256 * 1024;
constexpr size_t WS_WIN = 2 * MiB;
constexpr size_t WS_WCAT = 17 * MiB;
constexpr size_t WS_WOUT = 20 * MiB;
constexpr size_t WS_WGU = 22 * MiB;
constexpr size_t WS_WDN = 33 * MiB;
constexpr size_t WS_U = 42 * MiB;
constexpr size_t WS_ZQ = 74 * MiB;
constexpr size_t WS_MSCR = 74 * MiB;
constexpr size_t WS_Y = 138 * MiB;
constexpr size_t WS_ACT = 74 * MiB;
constexpr size_t WS_GATES = 218 * MiB;
constexpr size_t WS_Y2 = 218 * MiB;
constexpr size_t WS_OCAT = 314 * MiB;
constexpr size_t WS_PART = 354 * MiB;
constexpr size_t WS_PARTML = 450 * MiB;
constexpr size_t WS_MERGED = 354 * MiB;
constexpr size_t WS_CSCR = 453 * MiB;
constexpr size_t WS_CLSE = 477 * MiB;
constexpr size_t WS_END = 478 * MiB;

constexpr int RING_BYTES = 131072;
constexpr int MISC_OFF = RING_BYTES;
constexpr int LDS_BYTES = 147456;

#define RLX_AGENT __ATOMIC_RELAXED, __HIP_MEMORY_SCOPE_AGENT
__device__ __forceinline__ unsigned f2bf(float f) { unsigned u = __builtin_bit_cast(unsigned, f); return (u + 0x7fffu + ((u >> 16) & 1u)) >> 16; }
__device__ __forceinline__ unsigned pk2(float lo, float hi) { return f2bf(lo) | (f2bf(hi) << 16); }
__device__ __forceinline__ float bflo(unsigned w) { return __builtin_bit_cast(float, w << 16); }
__device__ __forceinline__ float bfhi(unsigned w) { return __builtin_bit_cast(float, w & 0xffff0000u); }
__device__ __forceinline__ unsigned cvt_pk_bf16(float lo, float hi) { unsigned r; asm volatile("v_cvt_pk_bf16_f32 %0, %1, %2" : "=v"(r) : "v"(lo), "v"(hi)); return r; }
__device__ __forceinline__ float fexp2(float x) { return __builtin_amdgcn_exp2f(x); }
__device__ __forceinline__ float frcp(float x) { return __builtin_amdgcn_rcpf(x); }
__device__ __forceinline__ float wave_sum(float v) {
#pragma unroll
    for (int o = 1; o < 64; o <<= 1) v += __shfl_xor(v, o);
    return v;
}
__device__ __forceinline__ float alibi_slope(int i) { return exp2f(-8.0f * (float)(i + 1) / 28.0f); }

namespace pg8 {
constexpr int BM = 256, BK = 64, HALF = 128, HTB = HALF * BK * 2, STAGE_BYTES = 8 * HTB, NXCD = 8, WGM = 8;
__host__ __device__ __forceinline__ int lds_byte(int r, int c) { const int st = (r >> 4) * 2 + (c >> 5), rr = r & 15, cc = c & 31, ob = rr * 64 + cc * 2; return st * 1024 + (ob ^ (((ob >> 9) & 1) << 5)); }
__host__ __device__ __forceinline__ void stage_rc(int b, int& R, int& C) { const int st = b / 1024, sb = b % 1024, swz = sb ^ (((sb >> 9) & 1) << 5); R = (st >> 1) * 16 + swz / 64; C = (st & 1) * 32 + (swz % 64) / 2; }
__host__ __device__ __forceinline__ int perm32(int rho) { const int n = rho >> 4, i = rho & 15; return 8 * (i >> 2) + 4 * n + (i & 3); }

struct Unit { int pm, pn, ko, nt, seg; };
struct Gemm { const bf16_t* A; const bf16_t* Bt; int lda, ldb; };

__host__ __device__ __forceinline__ void tile_of(int wgid, int nM, int nN, int& pm, int& pn) {
    const int nwg = nM * nN;
    { const int q = nwg / NXCD, r = nwg % NXCD, xcd = wgid % NXCD, off = wgid / NXCD; wgid = (xcd < r ? xcd * (q + 1) : r * (q + 1) + (xcd - r) * q) + off; }
    const int nig = WGM * nN, gid = wgid / nig, fm = gid * WGM, gsz = (nM - fm) < WGM ? (nM - fm) : WGM;
    pm = fm + ((wgid % nig) % gsz); pn = (wgid % nig) / gsz;
}
struct StaticOrder {
    int nM, nN, nwg, G, c, nt;
    __device__ void init(int M, int N, int K, int G_, int c_) { nM = M / BM; nN = N / BM; nwg = nM * nN; G = G_; c = c_; nt = K / BK; }
    __device__ bool next(int i, Unit& u) const {
        const long L = (long)i * G + c; if (L >= nwg) return false;
        tile_of((int)L, nM, nN, u.pm, u.pn); u.ko = 0; u.nt = nt; u.seg = 0; return true;
    }
};
struct MergeOrder {
    int nM, nN, nwg, G, c;
    __device__ void init(int M, int N, int G_, int c_) { nM = M / BM; nN = N / BM; nwg = nM * nN; G = G_; c = c_; }
    __device__ bool next(int i, Unit& u) const {
        const int seg = i % 3; const long L = (long)(i / 3) * G + c; if (L >= nwg) return false;
        tile_of((int)L, nM, nN, u.pm, u.pn); u.seg = seg; u.ko = seg * 512; u.nt = seg == 2 ? 4 : 8; return true;
    }
};

__device__ __forceinline__ float sigm(float x) { return frcp(1.0f + fexp2(-LOG2E * x)); }

struct EpiInproj {
    static constexpr bool PERM = true;
    bf16_t* zq; bf16_t* gates;
    __device__ __forceinline__ void operator()(const f32x4 (&acc)[2][2][4][2], const Unit& u, int wr, int wc, int fr, int fq) const {
        const int row0 = u.pm * BM + wr * 64 + fr;
        const bool isg = u.pn >= 18;
        const bool isq = (u.pn < 2) || (u.pn == 6) || (u.pn == 7) || (u.pn == 9) || (u.pn == 12) || (u.pn == 15);
        const float sc = isq ? QSCALE : 1.0f;
        bf16_t* base = isg ? gates : zq; const int ldc = isg ? NGATE : NQKV;
        const int col0 = (isg ? (u.pn - 18) : u.pn) * BM + wc * 32 + 8 * fq;
#pragma unroll
        for (int ai = 0; ai < 2; ++ai)
#pragma unroll
            for (int m = 0; m < 4; ++m) { bf16_t* rowp = base + (size_t)(row0 + ai * HALF + m * 16) * ldc + col0;
#pragma unroll
                for (int bj = 0; bj < 2; ++bj) { f32x4 v0 = acc[ai][bj][m][0], v1 = acc[ai][bj][m][1];
                    if (isg) { v0 = (f32x4){sigm(v0[0]), sigm(v0[1]), sigm(v0[2]), sigm(v0[3])}; v1 = (f32x4){sigm(v1[0]), sigm(v1[1]), sigm(v1[2]), sigm(v1[3])}; }
                    else { v0 = v0 * sc; v1 = v1 * sc; }
                    u32x4 w; w.x = cvt_pk_bf16(v0[0], v0[1]); w.y = cvt_pk_bf16(v0[2], v0[3]); w.z = cvt_pk_bf16(v1[0], v1[1]); w.w = cvt_pk_bf16(v1[2], v1[3]);
                    *(u32x4*)(rowp + bj * HALF) = w; } }
    }
};
struct EpiF32 {
    static constexpr bool PERM = false;
    float* C; int ldc;
    __device__ __forceinline__ void operator()(const f32x4 (&acc)[2][2][4][2], const Unit& u, int wr, int wc, int fr, int fq) const {
        const int row0 = u.pm * BM + wr * 64 + fr, col0 = u.pn * BM + wc * 32 + 4 * fq;
#pragma unroll
        for (int ai = 0; ai < 2; ++ai)
#pragma unroll
            for (int m = 0; m < 4; ++m) { float* rowp = C + (size_t)(row0 + ai * HALF + m * 16) * ldc + col0;
#pragma unroll
                for (int bj = 0; bj < 2; ++bj)
#pragma unroll
                    for (int n = 0; n < 2; ++n) *(f32x4*)(rowp + bj * HALF + n * 16) = acc[ai][bj][m][n]; }
    }
};
struct EpiSwiglu {
    static constexpr bool PERM = true;
    bf16_t* act;
    __device__ __forceinline__ void operator()(const f32x4 (&acc)[2][2][4][2], const Unit& u, int wr, int wc, int fr, int fq) const {
        const int row0 = u.pm * BM + wr * 64 + fr, col0 = u.pn * HALF + wc * 32 + 8 * fq;
#pragma unroll
        for (int ai = 0; ai < 2; ++ai)
#pragma unroll
            for (int m = 0; m < 4; ++m) { bf16_t* rowp = act + (size_t)(row0 + ai * HALF + m * 16) * DFF + col0;
                float r[8];
#pragma unroll
                for (int n = 0; n < 2; ++n)
#pragma unroll
                    for (int i = 0; i < 4; ++i) { const float g = acc[ai][0][m][n][i], up = acc[ai][1][m][n][i]; r[n * 4 + i] = g * sigm(g) * up; }
                u32x4 w; w.x = cvt_pk_bf16(r[0], r[1]); w.y = cvt_pk_bf16(r[2], r[3]); w.z = cvt_pk_bf16(r[4], r[5]); w.w = cvt_pk_bf16(r[6], r[7]);
                *(u32x4*)rowp = w; }
    }
};
struct EpiMerge {
    static constexpr bool PERM = true;
    const bf16_t* gates; float* scr; bf16_t* merged;
    __device__ __forceinline__ void operator()(const f32x4 (&acc)[2][2][4][2], const Unit& u, int wr, int wc, int fr, int fq) const {
        const int row0 = u.pm * BM + wr * 64 + fr, col0 = u.pn * BM + wc * 32 + 8 * fq;
#pragma unroll
        for (int ai = 0; ai < 2; ++ai)
#pragma unroll
            for (int m = 0; m < 4; ++m) { const size_t row = (size_t)(row0 + ai * HALF + m * 16);
#pragma unroll
                for (int bj = 0; bj < 2; ++bj) { const int col = col0 + bj * HALF;
                    const u32x4 gw = *(const u32x4*)(gates + row * NGATE + u.seg * D + col);
                    f32x4 v0 = acc[ai][bj][m][0], v1 = acc[ai][bj][m][1];
                    v0 = v0 * (f32x4){bflo(gw.x), bfhi(gw.x), bflo(gw.y), bfhi(gw.y)}; v1 = v1 * (f32x4){bflo(gw.z), bfhi(gw.z), bflo(gw.w), bfhi(gw.w)};
                    float* sp = scr + row * D + col;
                    if (u.seg > 0) { v0 = v0 + *(const f32x4*)sp; v1 = v1 + *(const f32x4*)(sp + 4); }
                    if (u.seg < 2) { *(f32x4*)sp = v0; *(f32x4*)(sp + 4) = v1; }
                    else { u32x4 w; w.x = cvt_pk_bf16(v0[0], v0[1]); w.y = cvt_pk_bf16(v0[2], v0[3]); w.z = cvt_pk_bf16(v1[0], v1[1]); w.w = cvt_pk_bf16(v1[2], v1[3]);
                        *(u32x4*)(merged + row * D + col) = w; } } }
    }
};

template <class Epi, class Sched, bool ALIGN_EPI>
__device__ __forceinline__ void gemm_phase(LAS unsigned char* lds, const Gemm g, const Sched& S, const Epi& E) {
    int tid = threadIdx.x; asm volatile("" : "+v"(tid));
    const int wid = __builtin_amdgcn_readfirstlane(tid >> 6), lane = tid & 63, wr = wid >> 2, wc = wid & 3, fr = lane & 15, fq = lane >> 4;
    unsigned voffA[2], voffB[2];
#pragma unroll
    for (int i = 0; i < 2; ++i) { int R, C; stage_rc(tid * 16 + i * 8192, R, C); const int Rb = Epi::PERM ? ((R & ~31) + perm32(R & 31)) : R;
        voffA[i] = (unsigned)(R * g.lda + C) * 2u; voffB[i] = (unsigned)(Rb * g.ldb + C) * 2u; }
    const size_t kstep = (size_t)(BK * 2);
    const size_t hstepA = (size_t)HALF * g.lda * 2, hstepB = (size_t)HALF * g.ldb * 2;
    const size_t tstepA = 2 * hstepA, tstepB = 2 * hstepB;
    const unsigned ldsw = (unsigned)wid * 1024u;
    const int aoff = lds_byte(wr * 64 + fr, fq * 8), boff = lds_byte(wc * 32 + fr, fq * 8);
#define PG8_SA(b, h) (((b) * 2 + (h)) * HTB)
#define PG8_SB(b, h) ((4 + (b) * 2 + (h)) * HTB)
#define PG8_STAGE(bufoff, gbase, voff) do { _Pragma("unroll") for (int _i = 0; _i < 2; ++_i) \
        __builtin_amdgcn_global_load_lds((const unsigned*)((const char*)(gbase) + (voff)[_i]), (LAS unsigned*)(lds + (bufoff) + ldsw + _i * 8192), 16, 0, 0); } while (0)
#define PG8_LDA(dst, b, h) do { _Pragma("unroll") for (int m = 0; m < 4; ++m) _Pragma("unroll") for (int k = 0; k < 2; ++k) dst[m][k] = *(const LAS bf16x8*)(lds + PG8_SA(b, h) + aoff + m * 2048 + k * 1024); } while (0)
#define PG8_LDB(dst, b, h) do { _Pragma("unroll") for (int n = 0; n < 2; ++n) _Pragma("unroll") for (int k = 0; k < 2; ++k) dst[n][k] = *(const LAS bf16x8*)(lds + PG8_SB(b, h) + boff + n * 2048 + k * 1024); } while (0)
#define PG8_MMA(ai, bj, At, Bt) do { __builtin_amdgcn_s_setprio(1); _Pragma("unroll") for (int m = 0; m < 4; ++m) _Pragma("unroll") for (int n = 0; n < 2; ++n) _Pragma("unroll") for (int k = 0; k < 2; ++k) \
        acc[ai][bj][m][n] = __builtin_amdgcn_mfma_f32_16x16x32_bf16(Bt[n][k], At[m][k], acc[ai][bj][m][n], 0, 0, 0); __builtin_amdgcn_s_setprio(0); } while (0)
#define PG8_WAIT_V(n) asm volatile("s_waitcnt vmcnt(" #n ")" ::: "memory")
#define PG8_WAIT_L(n) asm volatile("s_waitcnt lgkmcnt(" #n ")" ::: "memory")
#define PG8_BAR __builtin_amdgcn_s_barrier()
#define PG8_SCHED __builtin_amdgcn_sched_barrier(0)
    Unit cur, nxt; int ui = 0;
    if (!S.next(0, cur)) return;
    f32x4 acc[2][2][4][2];
#pragma unroll
    for (int a = 0; a < 2; ++a)
#pragma unroll
        for (int b = 0; b < 2; ++b)
#pragma unroll
            for (int m = 0; m < 4; ++m)
#pragma unroll
                for (int n = 0; n < 2; ++n) acc[a][b][m][n] = (f32x4){0.f, 0.f, 0.f, 0.f};
    bf16x8 At[4][2], B0[2][2], B1[2][2];
    const char* cA = (const char*)g.A + (size_t)cur.pm * tstepA + (size_t)cur.ko * 2; const char* cB = (const char*)g.Bt + (size_t)cur.pn * tstepB + (size_t)cur.ko * 2;
    PG8_STAGE(PG8_SB(0, 0), cB, voffB); PG8_STAGE(PG8_SB(0, 1), cB + hstepB, voffB); PG8_STAGE(PG8_SA(0, 0), cA, voffA); PG8_STAGE(PG8_SA(0, 1), cA + hstepA, voffA);
    if (wr == 1) PG8_BAR;
    PG8_WAIT_V(2); PG8_BAR;
    PG8_STAGE(PG8_SB(1, 0), cB + kstep, voffB); PG8_STAGE(PG8_SA(1, 0), cA + kstep, voffA); PG8_STAGE(PG8_SB(1, 1), cB + hstepB + kstep, voffB);
    PG8_WAIT_V(6); PG8_BAR;
    for (;;) {
        const bool has_next = S.next(ui + 1, nxt);
        const char* nA = has_next ? (const char*)g.A + (size_t)nxt.pm * tstepA + (size_t)nxt.ko * 2 : cA; const char* nB = has_next ? (const char*)g.Bt + (size_t)nxt.pn * tstepB + (size_t)nxt.ko * 2 : cB;
        const int nt = cur.nt;
        for (int t = 0; t < nt; t += 2) {
            const bool last = (t == nt - 2);
            const char* a1 = cA + (size_t)(t + 1) * kstep;
            const char* a2 = last ? nA : cA + (size_t)(t + 2) * kstep; const char* b2 = last ? nB : cB + (size_t)(t + 2) * kstep;
            const char* a3 = a2 + kstep; const char* b3 = b2 + kstep;
            PG8_LDB(B0, 0, 0); PG8_LDB(B1, 0, 1); PG8_SCHED; PG8_LDA(At, 0, 0); PG8_STAGE(PG8_SA(1, 1), a1 + hstepA, voffA);
            PG8_WAIT_V(8); PG8_WAIT_L(0); PG8_BAR; PG8_MMA(0, 0, At, B0); PG8_MMA(0, 1, At, B1); PG8_BAR; PG8_SCHED;
            PG8_LDA(At, 0, 1); PG8_STAGE(PG8_SB(0, 0), b2, voffB); PG8_STAGE(PG8_SB(0, 1), b2 + hstepB, voffB); PG8_STAGE(PG8_SA(0, 0), a2, voffA);
            PG8_WAIT_V(8); PG8_WAIT_L(0); PG8_BAR; PG8_MMA(1, 0, At, B0); PG8_MMA(1, 1, At, B1); PG8_BAR; PG8_SCHED;
            PG8_LDB(B0, 1, 0); PG8_LDB(B1, 1, 1); PG8_SCHED; PG8_LDA(At, 1, 0); PG8_STAGE(PG8_SA(0, 1), a2 + hstepA, voffA);
            PG8_WAIT_V(8); PG8_WAIT_L(0); PG8_BAR; PG8_MMA(0, 0, At, B0); PG8_MMA(0, 1, At, B1); PG8_BAR; PG8_SCHED;
            PG8_LDA(At, 1, 1); PG8_STAGE(PG8_SB(1, 0), b3, voffB); PG8_STAGE(PG8_SB(1, 1), b3 + hstepB, voffB); PG8_STAGE(PG8_SA(1, 0), a3, voffA);
            PG8_WAIT_V(8); PG8_WAIT_L(0); PG8_BAR; PG8_MMA(1, 0, At, B0); PG8_MMA(1, 1, At, B1); PG8_BAR; PG8_SCHED;
        }
        if constexpr (ALIGN_EPI) { if (wr == 0) PG8_BAR; }
        E(acc, cur, wr, wc, fr, fq);
        if (!has_next) break;
#pragma unroll
        for (int a = 0; a < 2; ++a)
#pragma unroll
            for (int b = 0; b < 2; ++b)
#pragma unroll
                for (int m = 0; m < 4; ++m)
#pragma unroll
                    for (int n = 0; n < 2; ++n) acc[a][b][m][n] = (f32x4){0.f, 0.f, 0.f, 0.f};
        cur = nxt; cA = nA; cB = nB; ++ui;
        if constexpr (ALIGN_EPI) { if (wr == 1) PG8_BAR; }
    }
    PG8_WAIT_V(0);
    if constexpr (!ALIGN_EPI) { if (wr == 0) PG8_BAR; }
    PG8_BAR;
#undef PG8_SA
#undef PG8_SB
#undef PG8_STAGE
#undef PG8_LDA
#undef PG8_LDB
#undef PG8_MMA
#undef PG8_WAIT_V
#undef PG8_WAIT_L
#undef PG8_BAR
#undef PG8_SCHED
}
}

#define XB_TMO      128
#define XB_XCNT(j)  (256  + 64 * (j))
#define XB_XSUB(j)  (1280 + 64 * (j))
#define XB_XGEN(j)  (2304 + 64 * (j))
#define XB_TOP      3328
#define XB_TOPGEN   3392
#define XCD_BAR_WORDS 3456
#define XB_SPIN_CAP (1u << 18)
__device__ __forceinline__ unsigned xb_ld(unsigned* p)              { return __hip_atomic_load(p, __ATOMIC_RELAXED, __HIP_MEMORY_SCOPE_AGENT); }
__device__ __forceinline__ unsigned xb_add(unsigned* p, unsigned v) { return __hip_atomic_fetch_add(p, v, __ATOMIC_RELAXED, __HIP_MEMORY_SCOPE_AGENT); }
__device__ __forceinline__ unsigned xb_xcc_id() { return (unsigned)__builtin_amdgcn_s_getreg((3 << 11) | 20) & 0xFu; }
#define XB_SPIN(cond, bar) do { unsigned _sp = 0; while (cond) { __builtin_amdgcn_s_sleep(1); \
    if ((++_sp & 255u) == 0u) { if (xb_ld(&(bar)[XB_TMO])) break; if (_sp > XB_SPIN_CAP) { atomicAdd(&(bar)[XB_TMO], 1u); break; } } } } while (0)
struct XcdBarrier { unsigned* bar; unsigned x; volatile LAS unsigned* st; };
__device__ __forceinline__ XcdBarrier xcd_barrier_post(unsigned* bar, volatile LAS unsigned* st) {
    XcdBarrier b; b.bar = bar; b.x = xb_xcc_id(); b.st = st;
    if (threadIdx.x == 0) (void)xb_add(&bar[XB_XCNT(b.x)], 1u);
    return b;
}
__device__ __forceinline__ void xcd_barrier_complete(unsigned* bar, unsigned x, unsigned& nloc, unsigned& nx) {
    const unsigned G = gridDim.x * gridDim.y * gridDim.z;
    unsigned sum, cnt, mine, sp = 0u;
    for (;;) {
        sum = 0u; cnt = 0u; mine = 0u;
#pragma unroll
        for (unsigned j = 0; j < 16; ++j) { const unsigned c = xb_ld(&bar[XB_XCNT(j)]); sum += c; cnt += (c > 0u) ? 1u : 0u; mine = (j == x) ? c : mine; }
        if (sum == G) break;
        __builtin_amdgcn_s_sleep(1);
        if ((++sp & 255u) == 0u) { if (xb_ld(&bar[XB_TMO])) break; if (sp > XB_SPIN_CAP) { atomicAdd(&bar[XB_TMO], 1u); break; } }
    }
    nloc = mine > 0u ? mine : 1u; nx = cnt > 0u ? cnt : 1u;
}
__device__ __forceinline__ void xcd_barrier(const XcdBarrier& b) {
    asm volatile("s_waitcnt vmcnt(0)" ::: "memory");
    __syncthreads();
    if (threadIdx.x == 0) {
        unsigned* bar = b.bar;
        __builtin_amdgcn_s_waitcnt(0);
        unsigned nloc = b.st[0], nx = b.st[1];
        if (nloc == 0u) { xcd_barrier_complete(bar, b.x, nloc, nx); b.st[0] = nloc; b.st[1] = nx; }
        const unsigned old = xb_add(&bar[XB_XSUB(b.x)], 1u);
        const unsigned gen = old / nloc;
        if (old + 1u == (gen + 1u) * nloc) {
            __builtin_amdgcn_fence(__ATOMIC_RELEASE, "agent");
            asm volatile("s_waitcnt vmcnt(0)" ::: "memory");
            const unsigned og = xb_add(&bar[XB_TOP], 1u);
            const unsigned tg = og / nx;
            if (og + 1u == (tg + 1u) * nx) xb_add(&bar[XB_TOPGEN], 1u);
            else XB_SPIN(xb_ld(&bar[XB_TOPGEN]) == tg, bar);
            __builtin_amdgcn_fence(__ATOMIC_ACQUIRE, "agent");
            xb_add(&bar[XB_XGEN(b.x)], 1u);
            asm volatile("s_waitcnt vmcnt(0)" ::: "memory");
        } else {
            XB_SPIN(xb_ld(&bar[XB_XGEN(b.x)]) == gen, bar);
            __builtin_amdgcn_fence(__ATOMIC_ACQUIRE, "agent");
            asm volatile("s_waitcnt vmcnt(0)" ::: "memory");
        }
    }
    __syncthreads();
}


__device__ __forceinline__ void transpose_item(const float* W, int N, bf16_t* WT, int ldt, int kofs, int k0, int n0, int drow0, LAS float* scr, int lane) {
#pragma unroll 8
    for (int i = 0; i < 32; ++i) { const int kk = 2 * i + (lane >> 5); scr[kk * 33 + (lane & 31)] = W[(size_t)(k0 + kk) * N + n0 + (lane & 31)]; }
    asm volatile("s_waitcnt lgkmcnt(0)" ::: "memory");
    const int c = lane & 7;
#pragma unroll
    for (int j = 0; j < 4; ++j) { const int n = (lane >> 3) + 8 * j; const LAS float* s = scr + (8 * c) * 33 + n;
        u32x4 o; o.x = pk2(s[0 * 33], s[1 * 33]); o.y = pk2(s[2 * 33], s[3 * 33]); o.z = pk2(s[4 * 33], s[5 * 33]); o.w = pk2(s[6 * 33], s[7 * 33]);
        *(u32x4*)(WT + (size_t)(drow0 + n) * ldt + kofs + k0 + 8 * c) = o; }
    asm volatile("s_waitcnt lgkmcnt(0)" ::: "memory");
}
__device__ __forceinline__ void convert_matrix(const float* W, int K, int N, bf16_t* WT, int ldt, int kofs, int mode, LAS float* scr, int gw, int ngw, int lane, int& first) {
    const int nblk = N / 32, nitems = (K / 64) * nblk;
    int it = gw - (first % ngw); if (it < 0) it += ngw;
    for (; it < nitems; it += ngw) {
        const int kb = it / nblk, nb = it % nblk, n0 = 32 * nb;
        const int drow0 = mode == 0 ? n0 : (256 * (n0 >> 7) + (n0 & 127) + (mode == 2 ? 128 : 0));
        transpose_item(W, N, WT, ldt, kofs, 64 * kb, n0, drow0, scr, lane);
    }
    first += nitems;
}

__device__ __forceinline__ void norm_rows(const float* y, const float* hin, float* hout, const float* Gv, const float* Av, const float* Bv, bf16_t* ub, int gw, int ngw, int lane) {
    f32x4 G[4], A[4], B[4];
#pragma unroll
    for (int j = 0; j < 4; ++j) {
        G[j] = y ? *(const f32x4*)(Gv + 4 * lane + 256 * j) : (f32x4){0.f, 0.f, 0.f, 0.f};
        A[j] = ub ? *(const f32x4*)(Av + 4 * lane + 256 * j) : (f32x4){0.f, 0.f, 0.f, 0.f};
        B[j] = ub ? *(const f32x4*)(Bv + 4 * lane + 256 * j) : (f32x4){0.f, 0.f, 0.f, 0.f};
    }
    for (int row = gw; row < S; row += ngw) {
        f32x4 h[4];
#pragma unroll
        for (int j = 0; j < 4; ++j) h[j] = *(const f32x4*)(hin + (size_t)row * D + 4 * lane + 256 * j);
        if (y) {
            f32x4 v[4]; float s = 0.f;
#pragma unroll
            for (int j = 0; j < 4; ++j) { v[j] = *(const f32x4*)(y + (size_t)row * D + 4 * lane + 256 * j); s += (v[j][0] * v[j][0] + v[j][1] * v[j][1]) + (v[j][2] * v[j][2] + v[j][3] * v[j][3]); }
            const float r = 1.0f / sqrtf(wave_sum(s) * (1.0f / D) + RMS_EPS);
#pragma unroll
            for (int j = 0; j < 4; ++j) { h[j] = h[j] + G[j] * (v[j] * r); *(f32x4*)(hout + (size_t)row * D + 4 * lane + 256 * j) = h[j]; }
        }
        if (ub) {
            float s = 0.f;
#pragma unroll
            for (int j = 0; j < 4; ++j) s += (h[j][0] * h[j][0] + h[j][1] * h[j][1]) + (h[j][2] * h[j][2] + h[j][3] * h[j][3]);
            const float r = 1.0f / sqrtf(wave_sum(s) * (1.0f / D) + RMS_EPS);
#pragma unroll
            for (int j = 0; j < 4; ++j) { const f32x4 o = (h[j] * r) * A[j] + B[j]; u32x2 w; w.x = pk2(o[0], o[1]); w.y = pk2(o[2], o[3]);
                *(u32x2*)(ub + (size_t)row * D + 4 * lane + 256 * j) = w; }
        }
    }
}

struct SAcc { float m, l; float o[64]; };
__device__ __forceinline__ void load_row64(const bf16_t* p, float (&q)[64]) {
#pragma unroll
    for (int c = 0; c < 8; ++c) { const u32x4 w = *(const u32x4*)(p + 8 * c);
        q[8 * c + 0] = bflo(w.x); q[8 * c + 1] = bfhi(w.x); q[8 * c + 2] = bflo(w.y); q[8 * c + 3] = bfhi(w.y);
        q[8 * c + 4] = bflo(w.z); q[8 * c + 5] = bfhi(w.z); q[8 * c + 6] = bflo(w.w); q[8 * c + 7] = bfhi(w.w); }
}
__device__ __forceinline__ void attend_key(SAcc& a, const float (&q)[64], const bf16_t* kp, const bf16_t* vp, float bias) {
    float s0 = 0.f, s1 = 0.f;
#pragma unroll
    for (int c = 0; c < 8; ++c) { const u32x4 w = *(const u32x4*)(kp + 8 * c);
        s0 += q[8 * c + 0] * bflo(w.x); s1 += q[8 * c + 1] * bfhi(w.x); s0 += q[8 * c + 2] * bflo(w.y); s1 += q[8 * c + 3] * bfhi(w.y);
        s0 += q[8 * c + 4] * bflo(w.z); s1 += q[8 * c + 5] * bfhi(w.z); s0 += q[8 * c + 6] * bflo(w.w); s1 += q[8 * c + 7] * bfhi(w.w); }
    const float s = s0 + s1 + bias;
    const float mn = fmaxf(a.m, s), al = fexp2(a.m - mn), p = fexp2(s - mn);
    a.m = mn; a.l = a.l * al + p;
#pragma unroll
    for (int c = 0; c < 8; ++c) { const u32x4 w = *(const u32x4*)(vp + 8 * c);
        a.o[8 * c + 0] = a.o[8 * c + 0] * al + p * bflo(w.x); a.o[8 * c + 1] = a.o[8 * c + 1] * al + p * bfhi(w.x);
        a.o[8 * c + 2] = a.o[8 * c + 2] * al + p * bflo(w.y); a.o[8 * c + 3] = a.o[8 * c + 3] * al + p * bfhi(w.y);
        a.o[8 * c + 4] = a.o[8 * c + 4] * al + p * bflo(w.z); a.o[8 * c + 5] = a.o[8 * c + 5] * al + p * bfhi(w.z);
        a.o[8 * c + 6] = a.o[8 * c + 6] * al + p * bflo(w.w); a.o[8 * c + 7] = a.o[8 * c + 7] * al + p * bfhi(w.w); }
}
__device__ __forceinline__ void store_row64_bf16(bf16_t* p, const float (&o)[64], float sc) {
#pragma unroll
    for (int c = 0; c < 8; ++c) { u32x4 w; w.x = pk2(o[8 * c] * sc, o[8 * c + 1] * sc); w.y = pk2(o[8 * c + 2] * sc, o[8 * c + 3] * sc); w.z = pk2(o[8 * c + 4] * sc, o[8 * c + 5] * sc); w.w = pk2(o[8 * c + 6] * sc, o[8 * c + 7] * sc);
        *(u32x4*)(p + 8 * c) = w; }
}

typedef __attribute__((address_space(4))) const unsigned long long* karg_t;
__device__ __forceinline__ const float* in_ptr(int i) { int off = i; asm volatile("" : "+s"(off)); karg_t k = (karg_t)__builtin_amdgcn_kernarg_segment_ptr(); return (const float*)k[off]; }
__device__ __forceinline__ float* out_ptr() { int off = 17; asm volatile("" : "+s"(off)); karg_t k = (karg_t)__builtin_amdgcn_kernarg_segment_ptr(); return (float*)k[off]; }
__device__ __forceinline__ unsigned char* ws_ptr() { int off = 18; asm volatile("" : "+s"(off)); karg_t k = (karg_t)__builtin_amdgcn_kernarg_segment_ptr(); return (unsigned char*)k[off]; }
struct Ctx { int tid, lane, wave, G, bx, vcu, gw, ngw; };
__device__ __forceinline__ Ctx make_ctx() {
    Ctx c; int t = threadIdx.x; asm volatile("" : "+v"(t)); c.tid = t; c.lane = t & 63; c.wave = __builtin_amdgcn_readfirstlane(t >> 6);
    int g = gridDim.x, b = blockIdx.x; asm volatile("" : "+s"(g), "+s"(b)); c.G = g; c.bx = b;
    c.vcu = (g % 8 == 0) ? (b % 8) * (g / 8) + b / 8 : b; c.gw = c.vcu * NWAVES + c.wave; c.ngw = g * NWAVES; return c;
}

__device__ __forceinline__ void ph_adaln_convert0(LAS unsigned char* lds) {
    const Ctx c = make_ctx(); unsigned char* ws = ws_ptr();
    const float* cvec = in_ptr(1); const float* w_ada = in_ptr(2); const float* b_ada = in_ptr(3);
    float* mod = (float*)(ws + WS_MOD);
    LAS float* red = (LAS float*)lds;
    for (int unit = c.vcu; unit < DEPTH * 96; unit += c.G) {
        const int l = unit / 96, n0 = (unit % 96) * 64;
        const float* W = w_ada + (size_t)l * D * 6 * D + n0 + c.lane;
        float a = 0.f;
#pragma unroll 8
        for (int k = c.wave * 128; k < c.wave * 128 + 128; ++k) { const float cv = cvec[k]; const float sl = cv * frcp(1.0f + __expf(-cv)); a += sl * W[(size_t)k * (6 * D)]; }
        red[c.wave * 64 + c.lane] = a;
        __syncthreads();
        if (c.wave == 0) { float s = 0.f;
#pragma unroll
            for (int w = 0; w < 8; ++w) s += red[w * 64 + c.lane];
            mod[((size_t)l * 12 + 6) * D + n0 + c.lane] = s + b_ada[(size_t)l * 6 * D + n0 + c.lane]; }
        __syncthreads();
    }
}
__device__ __forceinline__ void ph_convert(LAS unsigned char* lds, int n, int which) {
    const Ctx c = make_ctx(); unsigned char* ws = ws_ptr();
    LAS float* scr = (LAS float*)(lds + c.wave * 16384);
    int first = 0;
    if (which & 1) convert_matrix(in_ptr(6) + (size_t)n * D * NIN, D, NIN, (bf16_t*)(ws + WS_WIN), D, 0, 0, scr, c.gw, c.ngw, c.lane, first);
    if (which & 2) {
        convert_matrix(in_ptr(8) + (size_t)n * 512 * D, 512, D, (bf16_t*)(ws + WS_WCAT), KCAT, 0, 0, scr, c.gw, c.ngw, c.lane, first);
        convert_matrix(in_ptr(9) + (size_t)n * 512 * D, 512, D, (bf16_t*)(ws + WS_WCAT), KCAT, 512, 0, scr, c.gw, c.ngw, c.lane, first);
        convert_matrix(in_ptr(10) + (size_t)n * 256 * D, 256, D, (bf16_t*)(ws + WS_WCAT), KCAT, 1024, 0, scr, c.gw, c.ngw, c.lane, first);
        convert_matrix(in_ptr(11) + (size_t)n * D * D, D, D, (bf16_t*)(ws + WS_WOUT), D, 0, 0, scr, c.gw, c.ngw, c.lane, first);
        convert_matrix(in_ptr(14) + (size_t)n * D * DFF, D, DFF, (bf16_t*)(ws + WS_WGU), D, 0, 1, scr, c.gw, c.ngw, c.lane, first);
        convert_matrix(in_ptr(15) + (size_t)n * D * DFF, D, DFF, (bf16_t*)(ws + WS_WGU), D, 0, 2, scr, c.gw, c.ngw, c.lane, first);
        convert_matrix(in_ptr(16) + (size_t)n * DFF * D, DFF, D, (bf16_t*)(ws + WS_WDN), DFF, 0, 0, scr, c.gw, c.ngw, c.lane, first);
    }
}
__device__ __forceinline__ void ph_modtables() {
    const Ctx c = make_ctx(); unsigned char* ws = ws_ptr();
    float* mod = (float*)(ws + WS_MOD);
    const float* g_pre_mix = in_ptr(4); const float* g_post_mix = in_ptr(5); const float* g_pre_ffn = in_ptr(12); const float* g_post_ffn = in_ptr(13);
    for (int i = c.bx * NTHREADS + c.tid; i < DEPTH * D; i += c.G * NTHREADS) {
        const int l = i / D, n = i % D; float* m = mod + (size_t)l * 12 * D;
        const float sh1 = m[6 * D + n], sc1 = m[7 * D + n], gt1 = m[8 * D + n], sh2 = m[9 * D + n], sc2 = m[10 * D + n], gt2 = m[11 * D + n];
        m[0 * D + n] = g_pre_mix[l * D + n] * (1.0f + sc1); m[1 * D + n] = sh1; m[2 * D + n] = gt1 * g_post_mix[l * D + n];
        m[3 * D + n] = g_pre_ffn[l * D + n] * (1.0f + sc2); m[4 * D + n] = sh2; m[5 * D + n] = gt2 * g_post_ffn[l * D + n];
    }
}
__device__ __forceinline__ void ph_norm(int kind, int l) {
    const Ctx c = make_ctx(); unsigned char* ws = ws_ptr();
    const float* mod = (const float*)(ws + WS_MOD); const float* modl = mod + (size_t)l * 12 * D;
    bf16_t* ub = (bf16_t*)(ws + WS_U); float* out = out_ptr();
    if (kind == 0) norm_rows(nullptr, in_ptr(0), nullptr, nullptr, mod + 0 * D, mod + 1 * D, ub, c.gw, c.ngw, c.lane);
    else if (kind == 1) norm_rows((const float*)(ws + WS_Y), l == 0 ? in_ptr(0) : out, out, modl + 2 * D, modl + 3 * D, modl + 4 * D, ub, c.gw, c.ngw, c.lane);
    else norm_rows((const float*)(ws + WS_Y2), out, out, modl + 5 * D, modl + 12 * D, modl + 13 * D, (l + 1 < DEPTH) ? ub : nullptr, c.gw, c.ngw, c.lane);
}
__device__ __forceinline__ void ph_inproj(LAS unsigned char* lds) {
    const Ctx c = make_ctx(); unsigned char* ws = ws_ptr();
    pg8::Gemm g{(const bf16_t*)(ws + WS_U), (const bf16_t*)(ws + WS_WIN), D, D}; pg8::StaticOrder So; So.init(S, NIN, D, c.G, c.bx);
    pg8::EpiInproj E{(bf16_t*)(ws + WS_ZQ), (bf16_t*)(ws + WS_GATES)};
    pg8::gemm_phase<pg8::EpiInproj, pg8::StaticOrder, true>(lds, g, So, E);
}
__device__ __forceinline__ void ph_merge(LAS unsigned char* lds) {
    const Ctx c = make_ctx(); unsigned char* ws = ws_ptr();
    pg8::Gemm g{(const bf16_t*)(ws + WS_OCAT), (const bf16_t*)(ws + WS_WCAT), KCAT, KCAT}; pg8::MergeOrder So; So.init(S, D, c.G, c.bx);
    pg8::EpiMerge E{(const bf16_t*)(ws + WS_GATES), (float*)(ws + WS_MSCR), (bf16_t*)(ws + WS_MERGED)};
    pg8::gemm_phase<pg8::EpiMerge, pg8::MergeOrder, false>(lds, g, So, E);
}
__device__ __forceinline__ void ph_wout(LAS unsigned char* lds) {
    const Ctx c = make_ctx(); unsigned char* ws = ws_ptr();
    pg8::Gemm g{(const bf16_t*)(ws + WS_MERGED), (const bf16_t*)(ws + WS_WOUT), D, D}; pg8::StaticOrder So; So.init(S, D, D, c.G, c.bx);
    pg8::EpiF32 E{(float*)(ws + WS_Y), D};
    pg8::gemm_phase<pg8::EpiF32, pg8::StaticOrder, false>(lds, g, So, E);
}
__device__ __forceinline__ void ph_gateup(LAS unsigned char* lds) {
    const Ctx c = make_ctx(); unsigned char* ws = ws_ptr();
    pg8::Gemm g{(const bf16_t*)(ws + WS_U), (const bf16_t*)(ws + WS_WGU), D, D}; pg8::StaticOrder So; So.init(S, NGU, D, c.G, c.bx);
    pg8::EpiSwiglu E{(bf16_t*)(ws + WS_ACT)};
    pg8::gemm_phase<pg8::EpiSwiglu, pg8::StaticOrder, true>(lds, g, So, E);
}
__device__ __forceinline__ void ph_down(LAS unsigned char* lds) {
    const Ctx c = make_ctx(); unsigned char* ws = ws_ptr();
    pg8::Gemm g{(const bf16_t*)(ws + WS_ACT), (const bf16_t*)(ws + WS_WDN), DFF, DFF}; pg8::StaticOrder So; So.init(S, D, DFF, c.G, c.bx);
    pg8::EpiF32 E{(float*)(ws + WS_Y2), D};
    pg8::gemm_phase<pg8::EpiF32, pg8::StaticOrder, false>(lds, g, So, E);
}
__device__ __forceinline__ void ph_kmean() {
    const Ctx c = make_ctx(); unsigned char* ws = ws_ptr();
    unsigned* cnt = (unsigned*)(ws + WS_CNT); float* kmean = (float*)(ws + WS_KMEAN); const bf16_t* zq = (const bf16_t*)(ws + WS_ZQ);
    if (c.bx == 0) cnt[c.tid] = 0u;
    for (int item = c.gw; item < 512; item += c.ngw) {
        const int h = item >> 6, j = item & 63;
        const bf16_t* kp = zq + (size_t)(256 * j + (c.lane >> 3)) * NQKV + A_K + 64 * h + 8 * (c.lane & 7);
        float a[8];
#pragma unroll
        for (int i = 0; i < 8; ++i) a[i] = 0.f;
        for (int p = 0; p < 32; ++p) { const u32x4 w = *(const u32x4*)(kp + (size_t)(8 * p) * NQKV);
            a[0] += bflo(w.x); a[1] += bfhi(w.x); a[2] += bflo(w.y); a[3] += bfhi(w.y); a[4] += bflo(w.z); a[5] += bfhi(w.z); a[6] += bflo(w.w); a[7] += bfhi(w.w); }
#pragma unroll
        for (int i = 0; i < 8; ++i) { a[i] += __shfl_xor(a[i], 8); a[i] += __shfl_xor(a[i], 16); a[i] += __shfl_xor(a[i], 32); }
        if (c.lane < 8) {
#pragma unroll
            for (int i = 0; i < 8; ++i) kmean[(size_t)item * 64 + 8 * c.lane + i] = a[i] * (1.0f / 256.0f);
        }
    }
}
__device__ __forceinline__ void ph_topk(LAS unsigned char* lds) {
    const Ctx c = make_ctx(); unsigned char* ws = ws_ptr();
    const float* kmean = (const float*)(ws + WS_KMEAN); const bf16_t* zq = (const bf16_t*)(ws + WS_ZQ); unsigned char* sel = ws + WS_SEL;
    LAS float* km = (LAS float*)lds;
    for (int item = c.vcu; item < 256; item += c.G) {
        const int h = item >> 5, t = (item & 31) * 512 + c.tid, b = t >> 8;
        __syncthreads();
        for (int i = c.tid; i < 4096; i += NTHREADS) km[i] = kmean[(size_t)h * 4096 + i];
        __syncthreads();
        float q[64]; load_row64(zq + (size_t)t * NQKV + A_Q + 64 * h, q);
        float v1 = -INFINITY, v2 = -INFINITY, v3 = -INFINITY; int i1 = 0, i2 = 0, i3 = 0;
        for (int j = 0; j < b; ++j) {
            float g0 = 0.f, g1 = 0.f;
#pragma unroll
            for (int d = 0; d < 64; d += 4) { const f32x4 kv = *(const LAS f32x4*)(km + j * 64 + d); g0 += q[d] * kv[0]; g1 += q[d + 1] * kv[1]; g0 += q[d + 2] * kv[2]; g1 += q[d + 3] * kv[3]; }
            const float gsc = g0 + g1;
            const bool c1 = gsc > v1, c2 = gsc > v2, c3 = gsc > v3;
            v3 = c2 ? v2 : (c3 ? gsc : v3); i3 = c2 ? i2 : (c3 ? j : i3);
            v2 = c1 ? v1 : (c2 ? gsc : v2); i2 = c1 ? i1 : (c2 ? j : i2);
            v1 = c1 ? gsc : v1;             i1 = c1 ? j : i1;
        }
        const int nv = b < 3 ? b : 3;
        *(unsigned*)(sel + ((size_t)t * 8 + h) * 4) = (unsigned)i1 | ((unsigned)i2 << 8) | ((unsigned)i3 << 16) | ((unsigned)nv << 24);
    }
}
__device__ __forceinline__ void ph_att_scalar_moba() {
    const Ctx c = make_ctx(); unsigned char* ws = ws_ptr();
    const bf16_t* zq = (const bf16_t*)(ws + WS_ZQ); bf16_t* ocat = (bf16_t*)(ws + WS_OCAT); const unsigned char* sel = ws + WS_SEL;
    for (int item = c.vcu; item < 256; item += c.G) {
        const int h = item >> 5, t = (item & 31) * 512 + c.tid, b = t >> 8;
        const float sl2 = alibi_slope(20 + h) * LOG2E;
        float q[64]; load_row64(zq + (size_t)t * NQKV + A_Q + 64 * h, q);
        SAcc a; a.m = -1e30f; a.l = 0.f;
#pragma unroll
        for (int d = 0; d < 64; ++d) a.o[d] = 0.f;
        const unsigned sw = *(const unsigned*)(sel + ((size_t)t * 8 + h) * 4); const int nv = (int)(sw >> 24);
        for (int s = 0; s < nv; ++s) { const int j = (int)((sw >> (8 * s)) & 0xffu);
            for (int k = 0; k < 256; ++k) { const int tk = 256 * j + k; const bf16_t* rp = zq + (size_t)tk * NQKV + 64 * h;
                attend_key(a, q, rp + A_K, rp + A_V, -sl2 * (float)(t - tk)); } }
        for (int tk = 256 * b; tk <= t; ++tk) { const bf16_t* rp = zq + (size_t)tk * NQKV + 64 * h; attend_key(a, q, rp + A_K, rp + A_V, -sl2 * (float)(t - tk)); }
        store_row64_bf16(ocat + (size_t)t * KCAT + 64 * h, a.o, 1.0f / a.l);
    }
}
__device__ __forceinline__ void ph_att_scalar_swa(int l) {
    const Ctx c = make_ctx(); unsigned char* ws = ws_ptr();
    const bf16_t* zq = (const bf16_t*)(ws + WS_ZQ); bf16_t* ocat = (bf16_t*)(ws + WS_OCAT); const float* sinks = in_ptr(7);
    for (int item = c.vcu; item < 256; item += c.G) {
        const int hq = item >> 5, t = (item & 31) * 512 + c.tid, g = hq >> 2;
        const float sl2 = alibi_slope(hq) * LOG2E;
        float q[64]; load_row64(zq + (size_t)t * NQKV + B_Q + 64 * hq, q);
        SAcc a; a.m = sinks[l * 8 + hq] * LOG2E; a.l = 1.f;
#pragma unroll
        for (int d = 0; d < 64; ++d) a.o[d] = 0.f;
        const int t0 = t - 127 < 0 ? 0 : t - 127;
        for (int tk = t0; tk <= t; ++tk) { const bf16_t* rp = zq + (size_t)tk * NQKV + 64 * g; attend_key(a, q, rp + B_K, rp + B_V, -sl2 * (float)(t - tk)); }
        store_row64_bf16(ocat + (size_t)t * KCAT + 512 + 64 * hq, a.o, 1.0f / a.l);
    }
}
__device__ __forceinline__ void ph_att_scalar_dil() {
    const Ctx c = make_ctx(); unsigned char* ws = ws_ptr();
    const bf16_t* zq = (const bf16_t*)(ws + WS_ZQ); bf16_t* cscr = (bf16_t*)(ws + WS_CSCR); float* clse = (float*)(ws + WS_CLSE);
    for (int item = c.vcu; item < 384; item += c.G) {
        const int gc = item >> 5, g = gc >> 2, cc = gc & 3, t = (item & 31) * 512 + c.tid, dil = g == 0 ? 1 : (g == 1 ? 4 : 16);
        const float sl2 = alibi_slope(8 + gc) * LOG2E;
        const int qc = C_BASE + 768 * g + 64 * cc;
        float q[64]; load_row64(zq + (size_t)t * NQKV + qc, q);
        SAcc a; a.m = -1e30f; a.l = 0.f;
#pragma unroll
        for (int d = 0; d < 64; ++d) a.o[d] = 0.f;
        for (int s = 0; s <= 128; ++s) { const int tk = t - dil * s; if (tk < 0) break; const bf16_t* rp = zq + (size_t)tk * NQKV + qc; attend_key(a, q, rp + 256, rp + 512, -sl2 * (float)(dil * s)); }
        store_row64_bf16(cscr + ((size_t)(g * S + t) * 4 + cc) * 64, a.o, 1.0f / a.l);
        clse[(size_t)(g * S + t) * 4 + cc] = a.m + __log2f(a.l);
    }
}
__device__ __forceinline__ void ph_dil_combine() {
    const Ctx c = make_ctx(); unsigned char* ws = ws_ptr();
    const bf16_t* cscr = (const bf16_t*)(ws + WS_CSCR); const float* clse = (const float*)(ws + WS_CLSE); bf16_t* ocat = (bf16_t*)(ws + WS_OCAT);
    for (int i = c.bx * NTHREADS + c.tid; i < S * 4 * 16; i += c.G * NTHREADS) {
        const int t = i >> 6, cc = (i >> 4) & 3, d4 = (i & 15) * 4;
        const float l0 = clse[(size_t)(0 * S + t) * 4 + cc], l1 = clse[(size_t)(1 * S + t) * 4 + cc], l2 = clse[(size_t)(2 * S + t) * 4 + cc];
        const float mx = fmaxf(l0, fmaxf(l1, l2)); const float e0 = fexp2(l0 - mx), e1 = fexp2(l1 - mx), e2 = fexp2(l2 - mx), inv = 1.0f / (e0 + e1 + e2);
        const u32x2 w0 = *(const u32x2*)(cscr + ((size_t)(0 * S + t) * 4 + cc) * 64 + d4), w1 = *(const u32x2*)(cscr + ((size_t)(1 * S + t) * 4 + cc) * 64 + d4), w2 = *(const u32x2*)(cscr + ((size_t)(2 * S + t) * 4 + cc) * 64 + d4);
        const f32x4 o0 = (f32x4){bflo(w0.x), bfhi(w0.x), bflo(w0.y), bfhi(w0.y)}, o1 = (f32x4){bflo(w1.x), bfhi(w1.x), bflo(w1.y), bfhi(w1.y)}, o2 = (f32x4){bflo(w2.x), bfhi(w2.x), bflo(w2.y), bfhi(w2.y)};
        const f32x4 o = (o0 * e0 + o1 * e1 + o2 * e2) * inv;
        u32x2 w; w.x = pk2(o[0], o[1]); w.y = pk2(o[2], o[3]);
        *(u32x2*)(ocat + (size_t)t * KCAT + 1024 + 64 * cc + d4) = w;
    }
}

struct Args { const float* in[17]; float* out; unsigned char* ws; int ph_lo, ph_hi; };
__global__ void __launch_bounds__(NTHREADS, 2) trunk_fwd(Args args) {
    extern __shared__ __attribute__((aligned(16))) unsigned char lds_raw[];
    LAS unsigned char* lds = (LAS unsigned char*)lds_raw;
    volatile LAS unsigned* MISC = (volatile LAS unsigned*)(lds + MISC_OFF);
    if (threadIdx.x < 64) MISC[threadIdx.x] = 0u;
    __syncthreads();
    XcdBarrier bar; bar.bar = (unsigned*)(args.ws + WS_CTL); bar.x = 0; bar.st = nullptr;
#if !MK_MULTI
    bar = xcd_barrier_post((unsigned*)(args.ws + WS_CTL), MISC + 8);
#endif
    const int lo = args.ph_lo, hi = args.ph_hi;
    int step = 0;
#define PHASE_BEGIN if (step >= lo && step < hi) {
#if MK_MULTI
#define PHASE_END } ++step;
#else
#define PHASE_END if (step + 1 < hi) xcd_barrier(bar); } ++step;
#endif
    PHASE_BEGIN ph_adaln_convert0(lds); ph_convert(lds, 0, 3); PHASE_END
    PHASE_BEGIN ph_modtables(); PHASE_END
    PHASE_BEGIN ph_norm(0, 0); PHASE_END
    for (int l = 0; l < DEPTH; ++l) {
        PHASE_BEGIN ph_inproj(lds); PHASE_END
        PHASE_BEGIN ph_kmean(); if (l + 1 < DEPTH) ph_convert(lds, l + 1, 1); PHASE_END
        PHASE_BEGIN ph_topk(lds); PHASE_END
        PHASE_BEGIN ph_att_scalar_moba(); ph_att_scalar_swa(l); ph_att_scalar_dil(); PHASE_END
        PHASE_BEGIN ph_dil_combine(); PHASE_END
        PHASE_BEGIN ph_merge(lds); PHASE_END
        PHASE_BEGIN ph_wout(lds); PHASE_END
        PHASE_BEGIN ph_norm(1, l); PHASE_END
        PHASE_BEGIN ph_gateup(lds); PHASE_END
        PHASE_BEGIN ph_down(lds); PHASE_END
        PHASE_BEGIN ph_norm(2, l); if (l + 1 < DEPTH) ph_convert(lds, l + 1, 2); PHASE_END
    }
#undef PHASE_BEGIN
#undef PHASE_END
}
constexpr int N_STEPS = 3 + DEPTH * 11;

extern "C" void kernel_launch(void* const* d_in, const int* in_sizes, int n_in, void* d_out, int out_size, void* d_ws, size_t ws_size, hipStream_t stream) {
    static int grid = 0;
    if (grid == 0) {
        if (n_in != 17 || in_sizes[0] != S * D || out_size != S * D || ws_size < WS_END) { fprintf(stderr, "kernel_launch: unexpected shapes / workspace (%d inputs, ws %zu)\n", n_in, ws_size); grid = -1; return; }
        int dev = 0, cus = 0, per_cu = 0;
        if (hipGetDevice(&dev) != hipSuccess || hipDeviceGetAttribute(&cus, hipDeviceAttributeMultiprocessorCount, dev) != hipSuccess) { grid = -1; return; }
        if (hipFuncSetAttribute((const void*)trunk_fwd, hipFuncAttributeMaxDynamicSharedMemorySize, LDS_BYTES) != hipSuccess) { grid = -1; return; }
        if (hipOccupancyMaxActiveBlocksPerMultiprocessor(&per_cu, (const void*)trunk_fwd, NTHREADS, LDS_BYTES) != hipSuccess || per_cu < 1) { fprintf(stderr, "kernel_launch: occupancy query says %d\n", per_cu); }
        (void)hipGetLastError();
        grid = cus;
    }
    if (grid < 0) return;
    (void)hipMemsetAsync((char*)d_ws + WS_CTL, 0, CTL_ZERO_BYTES, stream);
    Args a{};
    for (int i = 0; i < 17; ++i) a.in[i] = (const float*)d_in[i];
    a.out = (float*)d_out; a.ws = (unsigned char*)d_ws;
#if MK_MULTI
#ifndef MK_MAX_STEP
#define MK_MAX_STEP N_STEPS
#endif
    for (int s = 0; s < MK_MAX_STEP; ++s) { a.ph_lo = s; a.ph_hi = s + 1; hipLaunchKernelGGL(trunk_fwd, dim3(grid), dim3(NTHREADS), LDS_BYTES, stream, a); }
#else
    a.ph_lo = 0; a.ph_hi = N_STEPS; hipLaunchKernelGGL(trunk_fwd, dim3(grid), dim3(NTHREADS), LDS_BYTES, stream, a);
#endif
}
```

```cpp
#include <hip/hip_runtime.h>
#include <cstdio>
#include <cstdint>

#ifndef ATT_SCALAR
#define ATT_SCALAR 0
#endif
#ifndef MK_MULTI
#define MK_MULTI 0
#endif

#define GAS __attribute__((address_space(1)))
#define LAS __attribute__((address_space(3)))
typedef unsigned short bf16_t;
typedef short bf16x8 __attribute__((ext_vector_type(8)));
typedef float f32x4 __attribute__((ext_vector_type(4)));
typedef float f32x2 __attribute__((ext_vector_type(2)));
typedef unsigned u32x4 __attribute__((ext_vector_type(4)));
typedef unsigned u32x2 __attribute__((ext_vector_type(2)));

constexpr int S = 16384, D = 1024, DEPTH = 4, HD = 64;
constexpr int NQKV = 4608, NGATE = 3072, NIN = 7680, DFF = 2816, NGU = 5632, KCAT = 1280;
constexpr int A_Q = 0, A_K = 512, A_V = 1024, B_Q = 1536, B_K = 2048, B_V = 2176, C_BASE = 2304;
constexpr float LOG2E = 1.4426950408889634f, QSCALE = 0.125f * LOG2E, RMS_EPS = 1e-6f;
constexpr int NWAVES = 8, NTHREADS = 512;

constexpr size_t MiB = 1u << 20;
constexpr size_t WS_CTL = 0, CTL_ZERO_BYTES = 64 * 1024;
constexpr size_t WS_CNT = 256 * 1024;
constexpr size_t WS_MOD = 512 * 1024;
constexpr size_t WS_KMEAN = 1 * MiB;
constexpr size_t WS_SEL = 1 * MiB + 256 * 1024;
constexpr size_t WS_WIN = 2 * MiB;
constexpr size_t WS_WCAT = 17 * MiB;
constexpr size_t WS_WOUT = 20 * MiB;
constexpr size_t WS_WGU = 22 * MiB;
constexpr size_t WS_WDN = 33 * MiB;
constexpr size_t WS_U = 42 * MiB;
constexpr size_t WS_ZQ = 74 * MiB;
constexpr size_t WS_MSCR = 74 * MiB;
constexpr size_t WS_Y = 138 * MiB;
constexpr size_t WS_ACT = 74 * MiB;
constexpr size_t WS_GATES = 218 * MiB;
constexpr size_t WS_Y2 = 218 * MiB;
constexpr size_t WS_OCAT = 314 * MiB;
constexpr size_t WS_PART = 354 * MiB;
constexpr size_t WS_PARTML = 450 * MiB;
constexpr size_t WS_MERGED = 354 * MiB;
constexpr size_t WS_CSCR = 453 * MiB;
constexpr size_t WS_CLSE = 477 * MiB;
constexpr size_t WS_END = 478 * MiB;

constexpr int RING_BYTES = 131072;
constexpr int MISC_OFF = RING_BYTES;
constexpr int LDS_BYTES = 147456;

#define RLX_AGENT __ATOMIC_RELAXED, __HIP_MEMORY_SCOPE_AGENT
__device__ __forceinline__ unsigned f2bf(float f) { unsigned u = __builtin_bit_cast(unsigned, f); return (u + 0x7fffu + ((u >> 16) & 1u)) >> 16; }
__device__ __forceinline__ unsigned pk2(float lo, float hi) { return f2bf(lo) | (f2bf(hi) << 16); }
__device__ __forceinline__ float bflo(unsigned w) { return __builtin_bit_cast(float, w << 16); }
__device__ __forceinline__ float bfhi(unsigned w) { return __builtin_bit_cast(float, w & 0xffff0000u); }
__device__ __forceinline__ unsigned cvt_pk_bf16(float lo, float hi) { unsigned r; asm volatile("v_cvt_pk_bf16_f32 %0, %1, %2" : "=v"(r) : "v"(lo), "v"(hi)); return r; }
__device__ __forceinline__ float fexp2(float x) { return __builtin_amdgcn_exp2f(x); }
__device__ __forceinline__ float frcp(float x) { return __builtin_amdgcn_rcpf(x); }
__device__ __forceinline__ float wave_sum(float v) {
#pragma unroll
    for (int o = 1; o < 64; o <<= 1) v += __shfl_xor(v, o);
    return v;
}
__device__ __forceinline__ float alibi_slope(int i) { return exp2f(-8.0f * (float)(i + 1) / 28.0f); }

namespace pg8 {
constexpr int BM = 256, BK = 64, HALF = 128, HTB = HALF * BK * 2, STAGE_BYTES = 8 * HTB, NXCD = 8, WGM = 8;
__host__ __device__ __forceinline__ int lds_byte(int r, int c) { const int st = (r >> 4) * 2 + (c >> 5), rr = r & 15, cc = c & 31, ob = rr * 64 + cc * 2; return st * 1024 + (ob ^ (((ob >> 9) & 1) << 5)); }
__host__ __device__ __forceinline__ void stage_rc(int b, int& R, int& C) { const int st = b / 1024, sb = b % 1024, swz = sb ^ (((sb >> 9) & 1) << 5); R = (st >> 1) * 16 + swz / 64; C = (st & 1) * 32 + (swz % 64) / 2; }
__host__ __device__ __forceinline__ int perm32(int rho) { const int n = rho >> 4, i = rho & 15; return 8 * (i >> 2) + 4 * n + (i & 3); }

struct Unit { int pm, pn, ko, nt, seg; };
struct Gemm { const bf16_t* A; const bf16_t* Bt; int lda, ldb; };

__host__ __device__ __forceinline__ void tile_of(int wgid, int nM, int nN, int& pm, int& pn) {
    const int nwg = nM * nN;
    { const int q = nwg / NXCD, r = nwg % NXCD, xcd = wgid % NXCD, off = wgid / NXCD; wgid = (xcd < r ? xcd * (q + 1) : r * (q + 1) + (xcd - r) * q) + off; }
    const int nig = WGM * nN, gid = wgid / nig, fm = gid * WGM, gsz = (nM - fm) < WGM ? (nM - fm) : WGM;
    pm = fm + ((wgid % nig) % gsz); pn = (wgid % nig) / gsz;
}
struct StaticOrder {
    int nM, nN, nwg, G, c, nt;
    __device__ void init(int M, int N, int K, int G_, int c_) { nM = M / BM; nN = N / BM; nwg = nM * nN; G = G_; c = c_; nt = K / BK; }
    __device__ bool next(int i, Unit& u) const {
        const long L = (long)i * G + c; if (L >= nwg) return false;
        tile_of((int)L, nM, nN, u.pm, u.pn); u.ko = 0; u.nt = nt; u.seg = 0; return true;
    }
};
struct MergeOrder {
    int nM, nN, nwg, G, c;
    __device__ void init(int M, int N, int G_, int c_) { nM = M / BM; nN = N / BM; nwg = nM * nN; G = G_; c = c_; }
    __device__ bool next(int i, Unit& u) const {
        const int seg = i % 3; const long L = (long)(i / 3) * G + c; if (L >= nwg) return false;
        tile_of((int)L, nM, nN, u.pm, u.pn); u.seg = seg; u.ko = seg * 512; u.nt = seg == 2 ? 4 : 8; return true;
    }
};

__device__ __forceinline__ float sigm(float x) { return frcp(1.0f + fexp2(-LOG2E * x)); }

struct EpiInproj {
    static constexpr bool PERM = true;
    bf16_t* zq; bf16_t* gates;
    __device__ __forceinline__ void operator()(const f32x4 (&acc)[2][2][4][2], const Unit& u, int wr, int wc, int fr, int fq) const {
        const int row0 = u.pm * BM + wr * 64 + fr;
        const bool isg = u.pn >= 18;
        const bool isq = (u.pn < 2) || (u.pn == 6) || (u.pn == 7) || (u.pn == 9) || (u.pn == 12) || (u.pn == 15);
        const float sc = isq ? QSCALE : 1.0f;
        bf16_t* base = isg ? gates : zq; const int ldc = isg ? NGATE : NQKV;
        const int col0 = (isg ? (u.pn - 18) : u.pn) * BM + wc * 32 + 8 * fq;
#pragma unroll
        for (int ai = 0; ai < 2; ++ai)
#pragma unroll
            for (int m = 0; m < 4; ++m) { bf16_t* rowp = base + (size_t)(row0 + ai * HALF + m * 16) * ldc + col0;
#pragma unroll
                for (int bj = 0; bj < 2; ++bj) { f32x4 v0 = acc[ai][bj][m][0], v1 = acc[ai][bj][m][1];
                    if (isg) { v0 = (f32x4){sigm(v0[0]), sigm(v0[1]), sigm(v0[2]), sigm(v0[3])}; v1 = (f32x4){sigm(v1[0]), sigm(v1[1]), sigm(v1[2]), sigm(v1[3])}; }
                    else { v0 = v0 * sc; v1 = v1 * sc; }
                    u32x4 w; w.x = cvt_pk_bf16(v0[0], v0[1]); w.y = cvt_pk_bf16(v0[2], v0[3]); w.z = cvt_pk_bf16(v1[0], v1[1]); w.w = cvt_pk_bf16(v1[2], v1[3]);
                    *(u32x4*)(rowp + bj * HALF) = w; } }
    }
};
struct EpiF32 {
    static constexpr bool PERM = false;
    float* C; int ldc;
    __device__ __forceinline__ void operator()(const f32x4 (&acc)[2][2][4][2], const Unit& u, int wr, int wc, int fr, int fq) const {
        const int row0 = u.pm * BM + wr * 64 + fr, col0 = u.pn * BM + wc * 32 + 4 * fq;
#pragma unroll
        for (int ai = 0; ai < 2; ++ai)
#pragma unroll
            for (int m = 0; m < 4; ++m) { float* rowp = C + (size_t)(row0 + ai * HALF + m * 16) * ldc + col0;
#pragma unroll
                for (int bj = 0; bj < 2; ++bj)
#pragma unroll
                    for (int n = 0; n < 2; ++n) *(f32x4*)(rowp + bj * HALF + n * 16) = acc[ai][bj][m][n]; }
    }
};
struct EpiSwiglu {
    static constexpr bool PERM = true;
    bf16_t* act;
    __device__ __forceinline__ void operator()(const f32x4 (&acc)[2][2][4][2], const Unit& u, int wr, int wc, int fr, int fq) const {
        const int row0 = u.pm * BM + wr * 64 + fr, col0 = u.pn * HALF + wc * 32 + 8 * fq;
#pragma unroll
        for (int ai = 0; ai < 2; ++ai)
#pragma unroll
            for (int m = 0; m < 4; ++m) { bf16_t* rowp = act + (size_t)(row0 + ai * HALF + m * 16) * DFF + col0;
                float r[8];
#pragma unroll
                for (int n = 0; n < 2; ++n)
#pragma unroll
                    for (int i = 0; i < 4; ++i) { const float g = acc[ai][0][m][n][i], up = acc[ai][1][m][n][i]; r[n * 4 + i] = g * sigm(g) * up; }
                u32x4 w; w.x = cvt_pk_bf16(r[0], r[1]); w.y = cvt_pk_bf16(r[2], r[3]); w.z = cvt_pk_bf16(r[4], r[5]); w.w = cvt_pk_bf16(r[6], r[7]);
                *(u32x4*)rowp = w; }
    }
};
struct EpiMerge {
    static constexpr bool PERM = true;
    const bf16_t* gates; float* scr; bf16_t* merged;
    __device__ __forceinline__ void operator()(const f32x4 (&acc)[2][2][4][2], const Unit& u, int wr, int wc, int fr, int fq) const {
        const int row0 = u.pm * BM + wr * 64 + fr, col0 = u.pn * BM + wc * 32 + 8 * fq;
#pragma unroll
        for (int ai = 0; ai < 2; ++ai)
#pragma unroll
            for (int m = 0; m < 4; ++m) { const size_t row = (size_t)(row0 + ai * HALF + m * 16);
#pragma unroll
                for (int bj = 0; bj < 2; ++bj) { const int col = col0 + bj * HALF;
                    const u32x4 gw = *(const u32x4*)(gates + row * NGATE + u.seg * D + col);
                    f32x4 v0 = acc[ai][bj][m][0], v1 = acc[ai][bj][m][1];
                    v0 = v0 * (f32x4){bflo(gw.x), bfhi(gw.x), bflo(gw.y), bfhi(gw.y)}; v1 = v1 * (f32x4){bflo(gw.z), bfhi(gw.z), bflo(gw.w), bfhi(gw.w)};
                    float* sp = scr + row * D + col;
                    if (u.seg > 0) { v0 = v0 + *(const f32x4*)sp; v1 = v1 + *(const f32x4*)(sp + 4); }
                    if (u.seg < 2) { *(f32x4*)sp = v0; *(f32x4*)(sp + 4) = v1; }
                    else { u32x4 w; w.x = cvt_pk_bf16(v0[0], v0[1]); w.y = cvt_pk_bf16(v0[2], v0[3]); w.z = cvt_pk_bf16(v1[0], v1[1]); w.w = cvt_pk_bf16(v1[2], v1[3]);
                        *(u32x4*)(merged + row * D + col) = w; } } }
    }
};

template <class Epi, class Sched, bool ALIGN_EPI>
__device__ __forceinline__ void gemm_phase(LAS unsigned char* lds, const Gemm g, const Sched& S, const Epi& E) {
    int tid = threadIdx.x; asm volatile("" : "+v"(tid));
    const int wid = __builtin_amdgcn_readfirstlane(tid >> 6), lane = tid & 63, wr = wid >> 2, wc = wid & 3, fr = lane & 15, fq = lane >> 4;
    unsigned voffA[2], voffB[2];
#pragma unroll
    for (int i = 0; i < 2; ++i) { int R, C; stage_rc(tid * 16 + i * 8192, R, C); const int Rb = Epi::PERM ? ((R & ~31) + perm32(R & 31)) : R;
        voffA[i] = (unsigned)(R * g.lda + C) * 2u; voffB[i] = (unsigned)(Rb * g.ldb + C) * 2u; }
    const size_t kstep = (size_t)(BK * 2);
    const size_t hstepA = (size_t)HALF * g.lda * 2, hstepB = (size_t)HALF * g.ldb * 2;
    const size_t tstepA = 2 * hstepA, tstepB = 2 * hstepB;
    const unsigned ldsw = (unsigned)wid * 1024u;
    const int aoff = lds_byte(wr * 64 + fr, fq * 8), boff = lds_byte(wc * 32 + fr, fq * 8);
#define PG8_SA(b, h) (((b) * 2 + (h)) * HTB)
#define PG8_SB(b, h) ((4 + (b) * 2 + (h)) * HTB)
#define PG8_STAGE(bufoff, gbase, voff) do { _Pragma("unroll") for (int _i = 0; _i < 2; ++_i) \
        __builtin_amdgcn_global_load_lds((const unsigned*)((const char*)(gbase) + (voff)[_i]), (LAS unsigned*)(lds + (bufoff) + ldsw + _i * 8192), 16, 0, 0); } while (0)
#define PG8_LDA(dst, b, h) do { _Pragma("unroll") for (int m = 0; m < 4; ++m) _Pragma("unroll") for (int k = 0; k < 2; ++k) dst[m][k] = *(const LAS bf16x8*)(lds + PG8_SA(b, h) + aoff + m * 2048 + k * 1024); } while (0)
#define PG8_LDB(dst, b, h) do { _Pragma("unroll") for (int n = 0; n < 2; ++n) _Pragma("unroll") for (int k = 0; k < 2; ++k) dst[n][k] = *(const LAS bf16x8*)(lds + PG8_SB(b, h) + boff + n * 2048 + k * 1024); } while (0)
#define PG8_MMA(ai, bj, At, Bt) do { __builtin_amdgcn_s_setprio(1); _Pragma("unroll") for (int m = 0; m < 4; ++m) _Pragma("unroll") for (int n = 0; n < 2; ++n) _Pragma("unroll") for (int k = 0; k < 2; ++k) \
        acc[ai][bj][m][n] = __builtin_amdgcn_mfma_f32_16x16x32_bf16(Bt[n][k], At[m][k], acc[ai][bj][m][n], 0, 0, 0); __builtin_amdgcn_s_setprio(0); } while (0)
#define PG8_WAIT_V(n) asm volatile("s_waitcnt vmcnt(" #n ")" ::: "memory")
#define PG8_WAIT_L(n) asm volatile("s_waitcnt lgkmcnt(" #n ")" ::: "memory")
#define PG8_BAR __builtin_amdgcn_s_barrier()
#define PG8_SCHED __builtin_amdgcn_sched_barrier(0)
    Unit cur, nxt; int ui = 0;
    if (!S.next(0, cur)) return;
    f32x4 acc[2][2][4][2];
#pragma unroll
    for (int a = 0; a < 2; ++a)
#pragma unroll
        for (int b = 0; b < 2; ++b)
#pragma unroll
            for (int m = 0; m < 4; ++m)
#pragma unroll
                for (int n = 0; n < 2; ++n) acc[a][b][m][n] = (f32x4){0.f, 0.f, 0.f, 0.f};
    bf16x8 At[4][2], B0[2][2], B1[2][2];
    const char* cA = (const char*)g.A + (size_t)cur.pm * tstepA + (size_t)cur.ko * 2; const char* cB = (const char*)g.Bt + (size_t)cur.pn * tstepB + (size_t)cur.ko * 2;
    PG8_STAGE(PG8_SB(0, 0), cB, voffB); PG8_STAGE(PG8_SB(0, 1), cB + hstepB, voffB); PG8_STAGE(PG8_SA(0, 0), cA, voffA); PG8_STAGE(PG8_SA(0, 1), cA + hstepA, voffA);
    if (wr == 1) PG8_BAR;
    PG8_WAIT_V(2); PG8_BAR;
    PG8_STAGE(PG8_SB(1, 0), cB + kstep, voffB); PG8_STAGE(PG8_SA(1, 0), cA + kstep, voffA); PG8_STAGE(PG8_SB(1, 1), cB + hstepB + kstep, voffB);
    PG8_WAIT_V(6); PG8_BAR;
    for (;;) {
        const bool has_next = S.next(ui + 1, nxt);
        const char* nA = has_next ? (const char*)g.A + (size_t)nxt.pm * tstepA + (size_t)nxt.ko * 2 : cA; const char* nB = has_next ? (const char*)g.Bt + (size_t)nxt.pn * tstepB + (size_t)nxt.ko * 2 : cB;
        const int nt = cur.nt;
        for (int t = 0; t < nt; t += 2) {
            const bool last = (t == nt - 2);
            const char* a1 = cA + (size_t)(t + 1) * kstep;
            const char* a2 = last ? nA : cA + (size_t)(t + 2) * kstep; const char* b2 = last ? nB : cB + (size_t)(t + 2) * kstep;
            const char* a3 = a2 + kstep; const char* b3 = b2 + kstep;
            PG8_LDB(B0, 0, 0); PG8_LDB(B1, 0, 1); PG8_SCHED; PG8_LDA(At, 0, 0); PG8_STAGE(PG8_SA(1, 1), a1 + hstepA, voffA);
            PG8_WAIT_V(8); PG8_WAIT_L(0); PG8_BAR; PG8_MMA(0, 0, At, B0); PG8_MMA(0, 1, At, B1); PG8_BAR; PG8_SCHED;
            PG8_LDA(At, 0, 1); PG8_STAGE(PG8_SB(0, 0), b2, voffB); PG8_STAGE(PG8_SB(0, 1), b2 + hstepB, voffB); PG8_STAGE(PG8_SA(0, 0), a2, voffA);
            PG8_WAIT_V(8); PG8_WAIT_L(0); PG8_BAR; PG8_MMA(1, 0, At, B0); PG8_MMA(1, 1, At, B1); PG8_BAR; PG8_SCHED;
            PG8_LDB(B0, 1, 0); PG8_LDB(B1, 1, 1); PG8_SCHED; PG8_LDA(At, 1, 0); PG8_STAGE(PG8_SA(0, 1), a2 + hstepA, voffA);
            PG8_WAIT_V(8); PG8_WAIT_L(0); PG8_BAR; PG8_MMA(0, 0, At, B0); PG8_MMA(0, 1, At, B1); PG8_BAR; PG8_SCHED;
            PG8_LDA(At, 1, 1); PG8_STAGE(PG8_SB(1, 0), b3, voffB); PG8_STAGE(PG8_SB(1, 1), b3 + hstepB, voffB); PG8_STAGE(PG8_SA(1, 0), a3, voffA);
            PG8_WAIT_V(8); PG8_WAIT_L(0); PG8_BAR; PG8_MMA(1, 0, At, B0); PG8_MMA(1, 1, At, B1); PG8_BAR; PG8_SCHED;
        }
        if constexpr (ALIGN_EPI) { if (wr == 0) PG8_BAR; }
        E(acc, cur, wr, wc, fr, fq);
        if (!has_next) break;
#pragma unroll
        for (int a = 0; a < 2; ++a)
#pragma unroll
            for (int b = 0; b < 2; ++b)
#pragma unroll
                for (int m = 0; m < 4; ++m)
#pragma unroll
                    for (int n = 0; n < 2; ++n) acc[a][b][m][n] = (f32x4){0.f, 0.f, 0.f, 0.f};
        cur = nxt; cA = nA; cB = nB; ++ui;
        if constexpr (ALIGN_EPI) { if (wr == 1) PG8_BAR; }
    }
    PG8_WAIT_V(0);
    if constexpr (!ALIGN_EPI) { if (wr == 0) PG8_BAR; }
    PG8_BAR;
#undef PG8_SA
#undef PG8_SB
#undef PG8_STAGE
#undef PG8_LDA
#undef PG8_LDB
#undef PG8_MMA
#undef PG8_WAIT_V
#undef PG8_WAIT_L
#undef PG8_BAR
#undef PG8_SCHED
}
}

#define XB_TMO      128
#define XB_XCNT(j)  (256  + 64 * (j))
#define XB_XSUB(j)  (1280 + 64 * (j))
#define XB_XGEN(j)  (2304 + 64 * (j))
#define XB_TOP      3328
#define XB_TOPGEN   3392
#define XCD_BAR_WORDS 3456
#define XB_SPIN_CAP (1u << 18)
__device__ __forceinline__ unsigned xb_ld(unsigned* p)              { return __hip_atomic_load(p, __ATOMIC_RELAXED, __HIP_MEMORY_SCOPE_AGENT); }
__device__ __forceinline__ unsigned xb_add(unsigned* p, unsigned v) { return __hip_atomic_fetch_add(p, v, __ATOMIC_RELAXED, __HIP_MEMORY_SCOPE_AGENT); }
__device__ __forceinline__ unsigned xb_xcc_id() { return (unsigned)__builtin_amdgcn_s_getreg((3 << 11) | 20) & 0xFu; }
#define XB_SPIN(cond, bar) do { unsigned _sp = 0; while (cond) { __builtin_amdgcn_s_sleep(1); \
    if ((++_sp & 255u) == 0u) { if (xb_ld(&(bar)[XB_TMO])) break; if (_sp > XB_SPIN_CAP) { atomicAdd(&(bar)[XB_TMO], 1u); break; } } } } while (0)
struct XcdBarrier { unsigned* bar; unsigned x; volatile LAS unsigned* st; };
__device__ __forceinline__ XcdBarrier xcd_barrier_post(unsigned* bar, volatile LAS unsigned* st) {
    XcdBarrier b; b.bar = bar; b.x = xb_xcc_id(); b.st = st;
    if (threadIdx.x == 0) (void)xb_add(&bar[XB_XCNT(b.x)], 1u);
    return b;
}
__device__ __forceinline__ void xcd_barrier_complete(unsigned* bar, unsigned x, unsigned& nloc, unsigned& nx) {
    const unsigned G = gridDim.x * gridDim.y * gridDim.z;
    unsigned sum, cnt, mine, sp = 0u;
    for (;;) {
        sum = 0u; cnt = 0u; mine = 0u;
#pragma unroll
        for (unsigned j = 0; j < 16; ++j) { const unsigned c = xb_ld(&bar[XB_XCNT(j)]); sum += c; cnt += (c > 0u) ? 1u : 0u; mine = (j == x) ? c : mine; }
        if (sum == G) break;
        __builtin_amdgcn_s_sleep(1);
        if ((++sp & 255u) == 0u) { if (xb_ld(&bar[XB_TMO])) break; if (sp > XB_SPIN_CAP) { atomicAdd(&bar[XB_TMO], 1u); break; } }
    }
    nloc = mine > 0u ? mine : 1u; nx = cnt > 0u ? cnt : 1u;
}
__device__ __forceinline__ void xcd_barrier(const XcdBarrier& b) {
    asm volatile("s_waitcnt vmcnt(0)" ::: "memory");
    __syncthreads();
    if (threadIdx.x == 0) {
        unsigned* bar = b.bar;
        __builtin_amdgcn_s_waitcnt(0);
        unsigned nloc = b.st[0], nx = b.st[1];
        if (nloc == 0u) { xcd_barrier_complete(bar, b.x, nloc, nx); b.st[0] = nloc; b.st[1] = nx; }
        const unsigned old = xb_add(&bar[XB_XSUB(b.x)], 1u);
        const unsigned gen = old / nloc;
        if (old + 1u == (gen + 1u) * nloc) {
            __builtin_amdgcn_fence(__ATOMIC_RELEASE, "agent");
            asm volatile("s_waitcnt vmcnt(0)" ::: "memory");
            const unsigned og = xb_add(&bar[XB_TOP], 1u);
            const unsigned tg = og / nx;
            if (og + 1u == (tg + 1u) * nx) xb_add(&bar[XB_TOPGEN], 1u);
            else XB_SPIN(xb_ld(&bar[XB_TOPGEN]) == tg, bar);
            __builtin_amdgcn_fence(__ATOMIC_ACQUIRE, "agent");
            xb_add(&bar[XB_XGEN(b.x)], 1u);
            asm volatile("s_waitcnt vmcnt(0)" ::: "memory");
        } else {
            XB_SPIN(xb_ld(&bar[XB_XGEN(b.x)]) == gen, bar);
            __builtin_amdgcn_fence(__ATOMIC_ACQUIRE, "agent");
            asm volatile("s_waitcnt vmcnt(0)" ::: "memory");
        }
    }
    __syncthreads();
}


__device__ __forceinline__ void transpose_item(const float* W, int N, bf16_t* WT, int ldt, int kofs, int k0, int n0, int drow0, LAS float* scr, int lane) {
#pragma unroll 8
    for (int i = 0; i < 32; ++i) { const int kk = 2 * i + (lane >> 5); scr[kk * 33 + (lane & 31)] = W[(size_t)(k0 + kk) * N + n0 + (lane & 31)]; }
    asm volatile("s_waitcnt lgkmcnt(0)" ::: "memory");
    const int c = lane & 7;
#pragma unroll
    for (int j = 0; j < 4; ++j) { const int n = (lane >> 3) + 8 * j; const LAS float* s = scr + (8 * c) * 33 + n;
        u32x4 o; o.x = pk2(s[0 * 33], s[1 * 33]); o.y = pk2(s[2 * 33], s[3 * 33]); o.z = pk2(s[4 * 33], s[5 * 33]); o.w = pk2(s[6 * 33], s[7 * 33]);
        *(u32x4*)(WT + (size_t)(drow0 + n) * ldt + kofs + k0 + 8 * c) = o; }
    asm volatile("s_waitcnt lgkmcnt(0)" ::: "memory");
}
__device__ __forceinline__ void convert_matrix(const float* W, int K, int N, bf16_t* WT, int ldt, int kofs, int mode, LAS float* scr, int gw, int ngw, int lane, int& first) {
    const int nblk = N / 32, nitems = (K / 64) * nblk;
    int it = gw - (first % ngw); if (it < 0) it += ngw;
    for (; it < nitems; it += ngw) {
        const int kb = it / nblk, nb = it % nblk, n0 = 32 * nb;
        const int drow0 = mode == 0 ? n0 : (256 * (n0 >> 7) + (n0 & 127) + (mode == 2 ? 128 : 0));
        transpose_item(W, N, WT, ldt, kofs, 64 * kb, n0, drow0, scr, lane);
    }
    first += nitems;
}

__device__ __forceinline__ void norm_rows(const float* y, const float* hin, float* hout, const float* Gv, const float* Av, const float* Bv, bf16_t* ub, int gw, int ngw, int lane) {
    f32x4 G[4], A[4], B[4];
#pragma unroll
    for (int j = 0; j < 4; ++j) {
        G[j] = y ? *(const f32x4*)(Gv + 4 * lane + 256 * j) : (f32x4){0.f, 0.f, 0.f, 0.f};
        A[j] = ub ? *(const f32x4*)(Av + 4 * lane + 256 * j) : (f32x4){0.f, 0.f, 0.f, 0.f};
        B[j] = ub ? *(const f32x4*)(Bv + 4 * lane + 256 * j) : (f32x4){0.f, 0.f, 0.f, 0.f};
    }
    for (int row = gw; row < S; row += ngw) {
        f32x4 h[4];
#pragma unroll
        for (int j = 0; j < 4; ++j) h[j] = *(const f32x4*)(hin + (size_t)row * D + 4 * lane + 256 * j);
        if (y) {
            f32x4 v[4]; float s = 0.f;
#pragma unroll
            for (int j = 0; j < 4; ++j) { v[j] = *(const f32x4*)(y + (size_t)row * D + 4 * lane + 256 * j); s += (v[j][0] * v[j][0] + v[j][1] * v[j][1]) + (v[j][2] * v[j][2] + v[j][3] * v[j][3]); }
            const float r = 1.0f / sqrtf(wave_sum(s) * (1.0f / D) + RMS_EPS);
#pragma unroll
            for (int j = 0; j < 4; ++j) { h[j] = h[j] + G[j] * (v[j] * r); *(f32x4*)(hout + (size_t)row * D + 4 * lane + 256 * j) = h[j]; }
        }
        if (ub) {
            float s = 0.f;
#pragma unroll
            for (int j = 0; j < 4; ++j) s += (h[j][0] * h[j][0] + h[j][1] * h[j][1]) + (h[j][2] * h[j][2] + h[j][3] * h[j][3]);
            const float r = 1.0f / sqrtf(wave_sum(s) * (1.0f / D) + RMS_EPS);
#pragma unroll
            for (int j = 0; j < 4; ++j) { const f32x4 o = (h[j] * r) * A[j] + B[j]; u32x2 w; w.x = pk2(o[0], o[1]); w.y = pk2(o[2], o[3]);
                *(u32x2*)(ub + (size_t)row * D + 4 * lane + 256 * j) = w; }
        }
    }
}

struct SAcc { float m, l; float o[64]; };
__device__ __forceinline__ void load_row64(const bf16_t* p, float (&q)[64]) {
#pragma unroll
    for (int c = 0; c < 8; ++c) { const u32x4 w = *(const u32x4*)(p + 8 * c);
        q[8 * c + 0] = bflo(w.x); q[8 * c + 1] = bfhi(w.x); q[8 * c + 2] = bflo(w.y); q[8 * c + 3] = bfhi(w.y);
        q[8 * c + 4] = bflo(w.z); q[8 * c + 5] = bfhi(w.z); q[8 * c + 6] = bflo(w.w); q[8 * c + 7] = bfhi(w.w); }
}
__device__ __forceinline__ void attend_key(SAcc& a, const float (&q)[64], const bf16_t* kp, const bf16_t* vp, float bias) {
    float s0 = 0.f, s1 = 0.f;
#pragma unroll
    for (int c = 0; c < 8; ++c) { const u32x4 w = *(const u32x4*)(kp + 8 * c);
        s0 += q[8 * c + 0] * bflo(w.x); s1 += q[8 * c + 1] * bfhi(w.x); s0 += q[8 * c + 2] * bflo(w.y); s1 += q[8 * c + 3] * bfhi(w.y);
        s0 += q[8 * c + 4] * bflo(w.z); s1 += q[8 * c + 5] * bfhi(w.z); s0 += q[8 * c + 6] * bflo(w.w); s1 += q[8 * c + 7] * bfhi(w.w); }
    const float s = s0 + s1 + bias;
    const float mn = fmaxf(a.m, s), al = fexp2(a.m - mn), p = fexp2(s - mn);
    a.m = mn; a.l = a.l * al + p;
#pragma unroll
    for (int c = 0; c < 8; ++c) { const u32x4 w = *(const u32x4*)(vp + 8 * c);
        a.o[8 * c + 0] = a.o[8 * c + 0] * al + p * bflo(w.x); a.o[8 * c + 1] = a.o[8 * c + 1] * al + p * bfhi(w.x);
        a.o[8 * c + 2] = a.o[8 * c + 2] * al + p * bflo(w.y); a.o[8 * c + 3] = a.o[8 * c + 3] * al + p * bfhi(w.y);
        a.o[8 * c + 4] = a.o[8 * c + 4] * al + p * bflo(w.z); a.o[8 * c + 5] = a.o[8 * c + 5] * al + p * bfhi(w.z);
        a.o[8 * c + 6] = a.o[8 * c + 6] * al + p * bflo(w.w); a.o[8 * c + 7] = a.o[8 * c + 7] * al + p * bfhi(w.w); }
}
__device__ __forceinline__ void store_row64_bf16(bf16_t* p, const float (&o)[64], float sc) {
#pragma unroll
    for (int c = 0; c < 8; ++c) { u32x4 w; w.x = pk2(o[8 * c] * sc, o[8 * c + 1] * sc); w.y = pk2(o[8 * c + 2] * sc, o[8 * c + 3] * sc); w.z = pk2(o[8 * c + 4] * sc, o[8 * c + 5] * sc); w.w = pk2(o[8 * c + 6] * sc, o[8 * c + 7] * sc);
        *(u32x4*)(p + 8 * c) = w; }
}

typedef __attribute__((address_space(4))) const unsigned long long* karg_t;
__device__ __forceinline__ const float* in_ptr(int i) { int off = i; asm volatile("" : "+s"(off)); karg_t k = (karg_t)__builtin_amdgcn_kernarg_segment_ptr(); return (const float*)k[off]; }
__device__ __forceinline__ float* out_ptr() { int off = 17; asm volatile("" : "+s"(off)); karg_t k = (karg_t)__builtin_amdgcn_kernarg_segment_ptr(); return (float*)k[off]; }
__device__ __forceinline__ unsigned char* ws_ptr() { int off = 18; asm volatile("" : "+s"(off)); karg_t k = (karg_t)__builtin_amdgcn_kernarg_segment_ptr(); return (unsigned char*)k[off]; }
struct Ctx { int tid, lane, wave, G, bx, vcu, gw, ngw; };
__device__ __forceinline__ Ctx make_ctx() {
    Ctx c; int t = threadIdx.x; asm volatile("" : "+v"(t)); c.tid = t; c.lane = t & 63; c.wave = __builtin_amdgcn_readfirstlane(t >> 6);
    int g = gridDim.x, b = blockIdx.x; asm volatile("" : "+s"(g), "+s"(b)); c.G = g; c.bx = b;
    c.vcu = (g % 8 == 0) ? (b % 8) * (g / 8) + b / 8 : b; c.gw = c.vcu * NWAVES + c.wave; c.ngw = g * NWAVES; return c;
}


typedef float f32x16 __attribute__((ext_vector_type(16)));
typedef short v4i16 __attribute__((ext_vector_type(4)));
constexpr int ATT_K_OFF = 0, ATT_V_OFF = 49152, ATT_MISC_OFF = 98304;
struct AttLane { int r32, hi; unsigned ka[4]; unsigned vb[2]; };
__device__ __forceinline__ AttLane att_lane(int lane) {
    AttLane L; L.r32 = lane & 31; L.hi = lane >> 5;
    const int x = (L.r32 >> 1) & 7;
#pragma unroll
    for (int s = 0; s < 4; ++s) L.ka[s] = (unsigned)(L.r32 * 128 + (((2 * s + L.hi) ^ x) * 16));
    const int i = lane & 15, q_ = i >> 2, p_ = i & 3, gb = (lane >> 4) & 1;
    const unsigned vbase = (unsigned)((4 * L.hi + q_) * 128 + ((4 * (q_ >> 1) + 2 * gb + (p_ >> 1)) * 16) + 8 * (p_ & 1));
    L.vb[0] = vbase; L.vb[1] = vbase ^ 64u; return L;
}
__device__ __forceinline__ float half_max(float v) { auto rr = __builtin_amdgcn_permlane32_swap(__float_as_uint(v), __float_as_uint(v), false, false); return fmaxf(__uint_as_float(rr[0]), __uint_as_float(rr[1])); }
__device__ __forceinline__ float half_sum(float v) { auto rr = __builtin_amdgcn_permlane32_swap(__float_as_uint(v), __float_as_uint(v), false, false); return __uint_as_float(rr[0]) + __uint_as_float(rr[1]); }
__device__ __forceinline__ v4i16 lds_tr(LAS const unsigned char* p) { return __builtin_amdgcn_ds_read_tr16_b64_v4i16((LAS v4i16*)p); }
struct QState { float m, l; f32x16 o0, o1; };
template <int VSWZ> __device__ __forceinline__ void stage_rows(LAS unsigned char* dst, const bf16_t* zq, int col, long tok0, int tokstride, int nrows, int tid) {
    for (int i = tid; i < nrows * 8; i += NTHREADS) { const int r = i >> 3, ch = i & 7; const long tok = tok0 + (long)r * tokstride;
        u32x4 v = (u32x4){0u, 0u, 0u, 0u}; if (tok >= 0) v = *(const u32x4*)(zq + (size_t)tok * NQKV + col + 8 * ch);
        const int cs = VSWZ ? (ch ^ (((r >> 1) & 1) << 2)) : (ch ^ ((r >> 1) & 7));
        *(LAS u32x4*)(dst + r * 128 + cs * 16) = v; }
}
template <bool MASK> __device__ __forceinline__ void att_tile(QState& st, const bf16x8 (&qf)[4], LAS const unsigned char* Kl, LAS const unsigned char* Vl, const AttLane& L, int kt,
                                                               float slope2d, int qpos, int dlo, int dhi, const f32x16& B0) {
    LAS const unsigned char* kp = Kl + kt * 4096;
    f32x16 p = B0;
#pragma unroll
    for (int s = 0; s < 4; ++s) { const bf16x8 kf = *(LAS const bf16x8*)(kp + L.ka[s]); p = __builtin_amdgcn_mfma_f32_32x32x16_bf16(kf, qf[s], p, 0, 0, 0); }
    const float ct = slope2d * (float)(32 * kt - qpos);
    if (MASK) { const int Dt = qpos - 32 * kt - 4 * L.hi;
#pragma unroll
        for (int r = 0; r < 16; ++r) { const int dist = Dt - ((r & 3) + 8 * (r >> 2)); p[r] = (dist >= dlo && dist <= dhi) ? p[r] : -INFINITY; } }
    float mt = fmaxf(p[0], p[1]);
#pragma unroll
    for (int r = 2; r < 16; ++r) mt = fmaxf(mt, p[r]);
    mt = half_max(mt) + ct;
    const float mn = fmaxf(st.m, mt), alpha = fexp2(st.m - mn), cm = ct - mn; st.m = mn;
    float rs = 0.f;
#pragma unroll
    for (int r = 0; r < 16; ++r) { p[r] = fexp2(p[r] + cm); rs += p[r]; }
    st.l = st.l * alpha + rs;
    st.o0 = st.o0 * alpha; st.o1 = st.o1 * alpha;
    u32x4 w0, w1;
    w0.x = cvt_pk_bf16(p[0], p[1]); w0.y = cvt_pk_bf16(p[2], p[3]); w0.z = cvt_pk_bf16(p[4], p[5]); w0.w = cvt_pk_bf16(p[6], p[7]);
    w1.x = cvt_pk_bf16(p[8], p[9]); w1.y = cvt_pk_bf16(p[10], p[11]); w1.z = cvt_pk_bf16(p[12], p[13]); w1.w = cvt_pk_bf16(p[14], p[15]);
    const bf16x8 pk0 = __builtin_bit_cast(bf16x8, w0), pk1 = __builtin_bit_cast(bf16x8, w1);
    LAS const unsigned char* vp = Vl + kt * 4096;
#define ATT_VF(d0, s2) ({ const v4i16 a_ = lds_tr(vp + L.vb[d0] + (s2) * 2048), b_ = lds_tr(vp + L.vb[d0] + (s2) * 2048 + 1024); (bf16x8){a_[0], a_[1], a_[2], a_[3], b_[0], b_[1], b_[2], b_[3]}; })
    { const bf16x8 v00 = ATT_VF(0, 0), v01 = ATT_VF(0, 1), v10 = ATT_VF(1, 0), v11 = ATT_VF(1, 1);
      st.o0 = __builtin_amdgcn_mfma_f32_32x32x16_bf16(v00, pk0, st.o0, 0, 0, 0); st.o1 = __builtin_amdgcn_mfma_f32_32x32x16_bf16(v10, pk0, st.o1, 0, 0, 0);
      st.o0 = __builtin_amdgcn_mfma_f32_32x32x16_bf16(v01, pk1, st.o0, 0, 0, 0); st.o1 = __builtin_amdgcn_mfma_f32_32x32x16_bf16(v11, pk1, st.o1, 0, 0, 0); }
#undef ATT_VF
}
__device__ __forceinline__ void att_init(QState& st, f32x16& B0, float slope2d, int hi) {
    st.m = -1e30f; st.l = 0.f;
#pragma unroll
    for (int r = 0; r < 16; ++r) { st.o0[r] = 0.f; st.o1[r] = 0.f; B0[r] = slope2d * (float)((r & 3) + 8 * (r >> 2) + 4 * hi); }
}
__device__ __forceinline__ void load_qf(bf16x8 (&qf)[4], const bf16_t* qrow, int hi) {
#pragma unroll
    for (int s = 0; s < 4; ++s) qf[s] = *(const bf16x8*)(qrow + 16 * s + 8 * hi);
}
__device__ __forceinline__ void store_o_bf16(bf16_t* orow, const QState& st, float sc, int hi) {
#pragma unroll
    for (int g4 = 0; g4 < 4; ++g4) {
        u32x2 a, b; a.x = cvt_pk_bf16(st.o0[4 * g4] * sc, st.o0[4 * g4 + 1] * sc); a.y = cvt_pk_bf16(st.o0[4 * g4 + 2] * sc, st.o0[4 * g4 + 3] * sc);
        b.x = cvt_pk_bf16(st.o1[4 * g4] * sc, st.o1[4 * g4 + 1] * sc); b.y = cvt_pk_bf16(st.o1[4 * g4 + 2] * sc, st.o1[4 * g4 + 3] * sc);
        *(u32x2*)(orow + 8 * g4 + 4 * hi) = a; *(u32x2*)(orow + 32 + 8 * g4 + 4 * hi) = b; }
}
__device__ __forceinline__ void att_unit_windowed(LAS unsigned char* lds, const Ctx& c, unsigned char* ws, int wu, int layer) {
    const bf16_t* zq = (const bf16_t*)(ws + WS_ZQ);
    int qcol, kcol, vcol, dil, res, np, max_steps, slope_i, kind, g = 0, cc = 0, hq = 0;
    if (wu < 512) { kind = 0; hq = wu >> 6; np = wu & 63; qcol = B_Q + 64 * hq; kcol = B_K + 64 * (hq >> 2); vcol = B_V + 64 * (hq >> 2); dil = 1; res = 0; max_steps = 127; slope_i = hq; }
    else { kind = 1; const int x = wu - 512, gc = x >> 6, y = x & 63; g = gc >> 2; cc = gc & 3; dil = g == 0 ? 1 : (g == 1 ? 4 : 16); const int per = 64 / dil; res = y / per; np = y % per;
        qcol = C_BASE + 768 * g + 64 * cc; kcol = qcol + 256; vcol = qcol + 512; max_steps = 128; slope_i = 8 + gc; }
    LAS unsigned char* Kl = lds + ATT_K_OFF; LAS unsigned char* Vl = lds + ATT_V_OFF;
    const long tok0 = (long)(256 * np - 128) * dil + res;
    __syncthreads();
    stage_rows<0>(Kl, zq, kcol, tok0, dil, 384, c.tid); stage_rows<1>(Vl, zq, vcol, tok0, dil, 384, c.tid);
    __syncthreads();
    const AttLane L = att_lane(c.lane);
    const int w = c.wave, qi = 32 * w + L.r32, t = (256 * np + qi) * dil + res, qpos = 128 + qi;
    bf16x8 qf[4]; load_qf(qf, zq + (size_t)t * NQKV + qcol, L.hi);
    const float slope2d = alibi_slope(slope_i) * LOG2E * (float)dil;
    QState st; f32x16 B0; att_init(st, B0, slope2d, L.hi);
    const int dhi = (np == 0 && qi < max_steps) ? qi : max_steps;
    if (np == 0) {
#pragma unroll 1
        for (int kt = w; kt < w + 5; ++kt) att_tile<true>(st, qf, Kl, Vl, L, kt, slope2d, qpos, 0, dhi, B0);
    } else {
        att_tile<true>(st, qf, Kl, Vl, L, w, slope2d, qpos, 0, dhi, B0);
#pragma unroll 1
        for (int kt = w + 1; kt < w + 4; ++kt) att_tile<false>(st, qf, Kl, Vl, L, kt, slope2d, qpos, 0, dhi, B0);
        att_tile<true>(st, qf, Kl, Vl, L, w + 4, slope2d, qpos, 0, dhi, B0);
    }
    const float lt = half_sum(st.l);
    if (kind == 0) {
        const float sink2 = in_ptr(7)[layer * 8 + hq] * LOG2E;
        const float mf = fmaxf(st.m, sink2), sc = fexp2(st.m - mf), lf = lt * sc + fexp2(sink2 - mf);
        store_o_bf16((bf16_t*)(ws + WS_OCAT) + (size_t)t * KCAT + 512 + 64 * hq, st, sc / lf, L.hi);
    } else {
        store_o_bf16((bf16_t*)(ws + WS_CSCR) + ((size_t)(g * S + t) * 4 + cc) * 64, st, 1.0f / lt, L.hi);
        if (L.hi == 0) ((float*)(ws + WS_CLSE))[(size_t)(g * S + t) * 4 + cc] = st.m + __log2f(lt);
    }
}
__device__ __forceinline__ void att_unit_moba_part(LAS unsigned char* lds, const Ctx& c, unsigned char* ws, int Lid, int ti) {
    const bf16_t* zq = (const bf16_t*)(ws + WS_ZQ);
    const int h = Lid >> 6, j = Lid & 63;
    LAS unsigned char* Kl = lds + ATT_K_OFF; LAS unsigned char* Vl = lds + ATT_V_OFF;
    __syncthreads();
    stage_rows<0>(Kl, zq, A_K + 64 * h, 256 * j, 1, 256, c.tid); stage_rows<1>(Vl, zq, A_V + 64 * h, 256 * j, 1, 256, c.tid);
    __syncthreads();
    const int n = (int)((const unsigned*)(ws + WS_CNT))[Lid];
    const int e0 = ti * 256 + 32 * c.wave;
    if (e0 >= n) return;
    const AttLane L = att_lane(c.lane);
    const int e = e0 + L.r32; const bool valid = e < n;
    const unsigned ent = ((const unsigned short*)(ws + WS_U))[(size_t)Lid * 16384 + (valid ? e : n - 1)];
    const int t = (int)(ent & 0x3fffu), slot = (int)(ent >> 14), qpos = t - 256 * j;
    bf16x8 qf[4]; load_qf(qf, zq + (size_t)t * NQKV + A_Q + 64 * h, L.hi);
    const float slope2d = alibi_slope(20 + h) * LOG2E;
    QState st; f32x16 B0; att_init(st, B0, slope2d, L.hi);
#pragma unroll 1
    for (int kt = 0; kt < 8; ++kt) att_tile<false>(st, qf, Kl, Vl, L, kt, slope2d, qpos, 0, 0, B0);
    const float lt = half_sum(st.l);
    if (valid) {
        float* pp = (float*)(ws + WS_PART) + ((size_t)(t * 8 + h) * 3 + slot) * 64;
#pragma unroll
        for (int g4 = 0; g4 < 4; ++g4) { *(f32x4*)(pp + 8 * g4 + 4 * L.hi) = (f32x4){st.o0[4 * g4], st.o0[4 * g4 + 1], st.o0[4 * g4 + 2], st.o0[4 * g4 + 3]};
            *(f32x4*)(pp + 32 + 8 * g4 + 4 * L.hi) = (f32x4){st.o1[4 * g4], st.o1[4 * g4 + 1], st.o1[4 * g4 + 2], st.o1[4 * g4 + 3]}; }
        if (L.hi == 0) *(f32x2*)((float*)(ws + WS_PARTML) + ((size_t)(t * 8 + h) * 3 + slot) * 2) = (f32x2){st.m, lt};
    }
}
__device__ __forceinline__ void att_unit_moba_own(LAS unsigned char* lds, const Ctx& c, unsigned char* ws, int h, int b) {
    const bf16_t* zq = (const bf16_t*)(ws + WS_ZQ);
    LAS unsigned char* Kl = lds + ATT_K_OFF; LAS unsigned char* Vl = lds + ATT_V_OFF;
    __syncthreads();
    stage_rows<0>(Kl, zq, A_K + 64 * h, 256 * b, 1, 256, c.tid); stage_rows<1>(Vl, zq, A_V + 64 * h, 256 * b, 1, 256, c.tid);
    __syncthreads();
    const AttLane L = att_lane(c.lane);
    const int w = c.wave, qi = 32 * w + L.r32, t = 256 * b + qi;
    bf16x8 qf[4]; load_qf(qf, zq + (size_t)t * NQKV + A_Q + 64 * h, L.hi);
    const float slope2d = alibi_slope(20 + h) * LOG2E;
    QState st; f32x16 B0; att_init(st, B0, slope2d, L.hi);
#pragma unroll 1
    for (int kt = 0; kt < w; ++kt) att_tile<false>(st, qf, Kl, Vl, L, kt, slope2d, qi, 0, 0, B0);
    att_tile<true>(st, qf, Kl, Vl, L, w, slope2d, qi, 0, 1 << 30, B0);
    float lt = half_sum(st.l);
    const int nv = b < 3 ? b : 3;
    const float* pml = (const float*)(ws + WS_PARTML) + (size_t)(t * 8 + h) * 6;
    const float* pp = (const float*)(ws + WS_PART) + (size_t)(t * 8 + h) * 192;
    float ms[3], ls[3]; float mt = st.m;
#pragma unroll
    for (int s = 0; s < 3; ++s) { ms[s] = -1e30f; ls[s] = 0.f; if (s < nv) { const f32x2 v = *(const f32x2*)(pml + 2 * s); ms[s] = v[0]; ls[s] = v[1]; mt = fmaxf(mt, ms[s]); } }
    const float a0 = fexp2(st.m - mt); lt *= a0; st.o0 = st.o0 * a0; st.o1 = st.o1 * a0;
#pragma unroll
    for (int s = 0; s < 3; ++s) if (s < nv) { const float as = fexp2(ms[s] - mt); lt += ls[s] * as;
#pragma unroll
        for (int g4 = 0; g4 < 4; ++g4) { const f32x4 x0 = *(const f32x4*)(pp + 64 * s + 8 * g4 + 4 * L.hi), x1 = *(const f32x4*)(pp + 64 * s + 32 + 8 * g4 + 4 * L.hi);
#pragma unroll
            for (int i = 0; i < 4; ++i) { st.o0[4 * g4 + i] += as * x0[i]; st.o1[4 * g4 + i] += as * x1[i]; } } }
    store_o_bf16((bf16_t*)(ws + WS_OCAT) + (size_t)t * KCAT + 64 * h, st, 1.0f / lt, L.hi);
}
__device__ __forceinline__ void ph_att1(LAS unsigned char* lds, int layer) {
    const Ctx c = make_ctx(); unsigned char* ws = ws_ptr();
    LAS unsigned* pre = (LAS unsigned*)(lds + ATT_MISC_OFF);
    LAS unsigned* wsum = pre + 520;
    { unsigned v = (((const unsigned*)(ws + WS_CNT))[c.tid] + 255u) >> 8;
#pragma unroll
      for (int o = 1; o < 64; o <<= 1) { const unsigned t2 = __shfl_up(v, o); if (c.lane >= o) v += t2; }
      if (c.lane == 63) wsum[c.wave] = v;
      __syncthreads();
      unsigned off = 0; for (int w2 = 0; w2 < c.wave; ++w2) off += wsum[w2];
      pre[c.tid + 1] = v + off; if (c.tid == 0) pre[0] = 0u;
      __syncthreads(); }
    const int total = (int)pre[512];
    for (int u = c.vcu; u < total + 1280; u += c.G) {
        if (u < total) { int lo = 0, hi = 512; while (hi - lo > 1) { const int mid = (lo + hi) >> 1; if ((int)pre[mid] <= u) lo = mid; else hi = mid; }
            att_unit_moba_part(lds, c, ws, lo, u - (int)pre[lo]); }
        else att_unit_windowed(lds, c, ws, u - total, layer);
    }
}
__device__ __forceinline__ void ph_att2(LAS unsigned char* lds) {
    const Ctx c = make_ctx(); unsigned char* ws = ws_ptr();
    for (int u = c.vcu; u < 512; u += c.G) att_unit_moba_own(lds, c, ws, u >> 6, u & 63);
}

__device__ __forceinline__ void ph_adaln_convert0(LAS unsigned char* lds) {
    const Ctx c = make_ctx(); unsigned char* ws = ws_ptr();
    const float* cvec = in_ptr(1); const float* w_ada = in_ptr(2); const float* b_ada = in_ptr(3);
    float* mod = (float*)(ws + WS_MOD);
    LAS float* red = (LAS float*)lds;
    for (int unit = c.vcu; unit < DEPTH * 96; unit += c.G) {
        const int l = unit / 96, n0 = (unit % 96) * 64;
        const float* W = w_ada + (size_t)l * D * 6 * D + n0 + c.lane;
        float a = 0.f;
#pragma unroll 8
        for (int k = c.wave * 128; k < c.wave * 128 + 128; ++k) { const float cv = cvec[k]; const float sl = cv * frcp(1.0f + __expf(-cv)); a += sl * W[(size_t)k * (6 * D)]; }
        red[c.wave * 64 + c.lane] = a;
        __syncthreads();
        if (c.wave == 0) { float s = 0.f;
#pragma unroll
            for (int w = 0; w < 8; ++w) s += red[w * 64 + c.lane];
            mod[((size_t)l * 12 + 6) * D + n0 + c.lane] = s + b_ada[(size_t)l * 6 * D + n0 + c.lane]; }
        __syncthreads();
    }
}
__device__ __forceinline__ void ph_convert(LAS unsigned char* lds, int n, int which) {
    const Ctx c = make_ctx(); unsigned char* ws = ws_ptr();
    LAS float* scr = (LAS float*)(lds + c.wave * 16384);
    int first = 0;
    if (which & 1) convert_matrix(in_ptr(6) + (size_t)n * D * NIN, D, NIN, (bf16_t*)(ws + WS_WIN), D, 0, 0, scr, c.gw, c.ngw, c.lane, first);
    if (which & 2) {
        convert_matrix(in_ptr(8) + (size_t)n * 512 * D, 512, D, (bf16_t*)(ws + WS_WCAT), KCAT, 0, 0, scr, c.gw, c.ngw, c.lane, first);
        convert_matrix(in_ptr(9) + (size_t)n * 512 * D, 512, D, (bf16_t*)(ws + WS_WCAT), KCAT, 512, 0, scr, c.gw, c.ngw, c.lane, first);
        convert_matrix(in_ptr(10) + (size_t)n * 256 * D, 256, D, (bf16_t*)(ws + WS_WCAT), KCAT, 1024, 0, scr, c.gw, c.ngw, c.lane, first);
        convert_matrix(in_ptr(11) + (size_t)n * D * D, D, D, (bf16_t*)(ws + WS_WOUT), D, 0, 0, scr, c.gw, c.ngw, c.lane, first);
        convert_matrix(in_ptr(14) + (size_t)n * D * DFF, D, DFF, (bf16_t*)(ws + WS_WGU), D, 0, 1, scr, c.gw, c.ngw, c.lane, first);
        convert_matrix(in_ptr(15) + (size_t)n * D * DFF, D, DFF, (bf16_t*)(ws + WS_WGU), D, 0, 2, scr, c.gw, c.ngw, c.lane, first);
        convert_matrix(in_ptr(16) + (size_t)n * DFF * D, DFF, D, (bf16_t*)(ws + WS_WDN), DFF, 0, 0, scr, c.gw, c.ngw, c.lane, first);
    }
}
__device__ __forceinline__ void ph_modtables() {
    const Ctx c = make_ctx(); unsigned char* ws = ws_ptr();
    float* mod = (float*)(ws + WS_MOD);
    const float* g_pre_mix = in_ptr(4); const float* g_post_mix = in_ptr(5); const float* g_pre_ffn = in_ptr(12); const float* g_post_ffn = in_ptr(13);
    for (int i = c.bx * NTHREADS + c.tid; i < DEPTH * D; i += c.G * NTHREADS) {
        const int l = i / D, n = i % D; float* m = mod + (size_t)l * 12 * D;
        const float sh1 = m[6 * D + n], sc1 = m[7 * D + n], gt1 = m[8 * D + n], sh2 = m[9 * D + n], sc2 = m[10 * D + n], gt2 = m[11 * D + n];
        m[0 * D + n] = g_pre_mix[l * D + n] * (1.0f + sc1); m[1 * D + n] = sh1; m[2 * D + n] = gt1 * g_post_mix[l * D + n];
        m[3 * D + n] = g_pre_ffn[l * D + n] * (1.0f + sc2); m[4 * D + n] = sh2; m[5 * D + n] = gt2 * g_post_ffn[l * D + n];
    }
}
__device__ __forceinline__ void ph_norm(int kind, int l) {
    const Ctx c = make_ctx(); unsigned char* ws = ws_ptr();
    const float* mod = (const float*)(ws + WS_MOD); const float* modl = mod + (size_t)l * 12 * D;
    bf16_t* ub = (bf16_t*)(ws + WS_U); float* out = out_ptr();
    if (kind == 0) norm_rows(nullptr, in_ptr(0), nullptr, nullptr, mod + 0 * D, mod + 1 * D, ub, c.gw, c.ngw, c.lane);
    else if (kind == 1) norm_rows((const float*)(ws + WS_Y), l == 0 ? in_ptr(0) : out, out, modl + 2 * D, modl + 3 * D, modl + 4 * D, ub, c.gw, c.ngw, c.lane);
    else norm_rows((const float*)(ws + WS_Y2), out, out, modl + 5 * D, modl + 12 * D, modl + 13 * D, (l + 1 < DEPTH) ? ub : nullptr, c.gw, c.ngw, c.lane);
}
__device__ __forceinline__ void ph_inproj(LAS unsigned char* lds) {
    const Ctx c = make_ctx(); unsigned char* ws = ws_ptr();
    pg8::Gemm g{(const bf16_t*)(ws + WS_U), (const bf16_t*)(ws + WS_WIN), D, D}; pg8::StaticOrder So; So.init(S, NIN, D, c.G, c.bx);
    pg8::EpiInproj E{(bf16_t*)(ws + WS_ZQ), (bf16_t*)(ws + WS_GATES)};
    pg8::gemm_phase<pg8::EpiInproj, pg8::StaticOrder, true>(lds, g, So, E);
}
__device__ __forceinline__ void ph_merge(LAS unsigned char* lds) {
    const Ctx c = make_ctx(); unsigned char* ws = ws_ptr();
    pg8::Gemm g{(const bf16_t*)(ws + WS_OCAT), (const bf16_t*)(ws + WS_WCAT), KCAT, KCAT}; pg8::MergeOrder So; So.init(S, D, c.G, c.bx);
    pg8::EpiMerge E{(const bf16_t*)(ws + WS_GATES), (float*)(ws + WS_MSCR), (bf16_t*)(ws + WS_MERGED)};
    pg8::gemm_phase<pg8::EpiMerge, pg8::MergeOrder, false>(lds, g, So, E);
}
__device__ __forceinline__ void ph_wout(LAS unsigned char* lds) {
    const Ctx c = make_ctx(); unsigned char* ws = ws_ptr();
    pg8::Gemm g{(const bf16_t*)(ws + WS_MERGED), (const bf16_t*)(ws + WS_WOUT), D, D}; pg8::StaticOrder So; So.init(S, D, D, c.G, c.bx);
    pg8::EpiF32 E{(float*)(ws + WS_Y), D};
    pg8::gemm_phase<pg8::EpiF32, pg8::StaticOrder, false>(lds, g, So, E);
}
__device__ __forceinline__ void ph_gateup(LAS unsigned char* lds) {
    const Ctx c = make_ctx(); unsigned char* ws = ws_ptr();
    pg8::Gemm g{(const bf16_t*)(ws + WS_U), (const bf16_t*)(ws + WS_WGU), D, D}; pg8::StaticOrder So; So.init(S, NGU, D, c.G, c.bx);
    pg8::EpiSwiglu E{(bf16_t*)(ws + WS_ACT)};
    pg8::gemm_phase<pg8::EpiSwiglu, pg8::StaticOrder, true>(lds, g, So, E);
}
__device__ __forceinline__ void ph_down(LAS unsigned char* lds) {
    const Ctx c = make_ctx(); unsigned char* ws = ws_ptr();
    pg8::Gemm g{(const bf16_t*)(ws + WS_ACT), (const bf16_t*)(ws + WS_WDN), DFF, DFF}; pg8::StaticOrder So; So.init(S, D, DFF, c.G, c.bx);
    pg8::EpiF32 E{(float*)(ws + WS_Y2), D};
    pg8::gemm_phase<pg8::EpiF32, pg8::StaticOrder, false>(lds, g, So, E);
}
__device__ __forceinline__ void ph_kmean() {
    const Ctx c = make_ctx(); unsigned char* ws = ws_ptr();
    unsigned* cnt = (unsigned*)(ws + WS_CNT); float* kmean = (float*)(ws + WS_KMEAN); const bf16_t* zq = (const bf16_t*)(ws + WS_ZQ);
    if (c.bx == 0) cnt[c.tid] = 0u;
    for (int item = c.gw; item < 512; item += c.ngw) {
        const int h = item >> 6, j = item & 63;
        const bf16_t* kp = zq + (size_t)(256 * j + (c.lane >> 3)) * NQKV + A_K + 64 * h + 8 * (c.lane & 7);
        float a[8];
#pragma unroll
        for (int i = 0; i < 8; ++i) a[i] = 0.f;
        for (int p = 0; p < 32; ++p) { const u32x4 w = *(const u32x4*)(kp + (size_t)(8 * p) * NQKV);
            a[0] += bflo(w.x); a[1] += bfhi(w.x); a[2] += bflo(w.y); a[3] += bfhi(w.y); a[4] += bflo(w.z); a[5] += bfhi(w.z); a[6] += bflo(w.w); a[7] += bfhi(w.w); }
#pragma unroll
        for (int i = 0; i < 8; ++i) { a[i] += __shfl_xor(a[i], 8); a[i] += __shfl_xor(a[i], 16); a[i] += __shfl_xor(a[i], 32); }
        if (c.lane < 8) {
#pragma unroll
            for (int i = 0; i < 8; ++i) kmean[(size_t)item * 64 + 8 * c.lane + i] = a[i] * (1.0f / 256.0f);
        }
    }
}
__device__ __forceinline__ void ph_topk(LAS unsigned char* lds) {
    const Ctx c = make_ctx(); unsigned char* ws = ws_ptr();
    const float* kmean = (const float*)(ws + WS_KMEAN); const bf16_t* zq = (const bf16_t*)(ws + WS_ZQ); unsigned char* sel = ws + WS_SEL;
    LAS float* km = (LAS float*)lds;
    for (int item = c.vcu; item < 256; item += c.G) {
        const int h = item >> 5, t = (item & 31) * 512 + c.tid, b = t >> 8;
        __syncthreads();
        for (int i = c.tid; i < 4096; i += NTHREADS) km[i] = kmean[(size_t)h * 4096 + i];
        __syncthreads();
        float q[64]; load_row64(zq + (size_t)t * NQKV + A_Q + 64 * h, q);
        float v1 = -INFINITY, v2 = -INFINITY, v3 = -INFINITY; int i1 = 0, i2 = 0, i3 = 0;
        for (int j = 0; j < b; ++j) {
            float g0 = 0.f, g1 = 0.f;
#pragma unroll
            for (int d = 0; d < 64; d += 4) { const f32x4 kv = *(const LAS f32x4*)(km + j * 64 + d); g0 += q[d] * kv[0]; g1 += q[d + 1] * kv[1]; g0 += q[d + 2] * kv[2]; g1 += q[d + 3] * kv[3]; }
            const float gsc = g0 + g1;
            const bool c1 = gsc > v1, c2 = gsc > v2, c3 = gsc > v3;
            v3 = c2 ? v2 : (c3 ? gsc : v3); i3 = c2 ? i2 : (c3 ? j : i3);
            v2 = c1 ? v1 : (c2 ? gsc : v2); i2 = c1 ? i1 : (c2 ? j : i2);
            v1 = c1 ? gsc : v1;             i1 = c1 ? j : i1;
        }
        const int nv = b < 3 ? b : 3;
        *(unsigned*)(sel + ((size_t)t * 8 + h) * 4) = (unsigned)i1 | ((unsigned)i2 << 8) | ((unsigned)i3 << 16) | ((unsigned)nv << 24);
        { unsigned* cnt = (unsigned*)(ws + WS_CNT); unsigned short* lists = (unsigned short*)(ws + WS_U);
          const int is[3] = {i1, i2, i3};
#pragma unroll
          for (int s = 0; s < 3; ++s) if (s < nv) { const int Lid = h * 64 + is[s]; const unsigned pos = atomicAdd(&cnt[Lid], 1u); lists[(size_t)Lid * 16384 + pos] = (unsigned short)(t | (s << 14)); } }
    }
}
__device__ __forceinline__ void ph_att_scalar_moba() {
    const Ctx c = make_ctx(); unsigned char* ws = ws_ptr();
    const bf16_t* zq = (const bf16_t*)(ws + WS_ZQ); bf16_t* ocat = (bf16_t*)(ws + WS_OCAT); const unsigned char* sel = ws + WS_SEL;
    for (int item = c.vcu; item < 256; item += c.G) {
        const int h = item >> 5, t = (item & 31) * 512 + c.tid, b = t >> 8;
        const float sl2 = alibi_slope(20 + h) * LOG2E;
        float q[64]; load_row64(zq + (size_t)t * NQKV + A_Q + 64 * h, q);
        SAcc a; a.m = -1e30f; a.l = 0.f;
#pragma unroll
        for (int d = 0; d < 64; ++d) a.o[d] = 0.f;
        const unsigned sw = *(const unsigned*)(sel + ((size_t)t * 8 + h) * 4); const int nv = (int)(sw >> 24);
        for (int s = 0; s < nv; ++s) { const int j = (int)((sw >> (8 * s)) & 0xffu);
            for (int k = 0; k < 256; ++k) { const int tk = 256 * j + k; const bf16_t* rp = zq + (size_t)tk * NQKV + 64 * h;
                attend_key(a, q, rp + A_K, rp + A_V, -sl2 * (float)(t - tk)); } }
        for (int tk = 256 * b; tk <= t; ++tk) { const bf16_t* rp = zq + (size_t)tk * NQKV + 64 * h; attend_key(a, q, rp + A_K, rp + A_V, -sl2 * (float)(t - tk)); }
        store_row64_bf16(ocat + (size_t)t * KCAT + 64 * h, a.o, 1.0f / a.l);
    }
}
__device__ __forceinline__ void ph_att_scalar_swa(int l) {
    const Ctx c = make_ctx(); unsigned char* ws = ws_ptr();
    const bf16_t* zq = (const bf16_t*)(ws + WS_ZQ); bf16_t* ocat = (bf16_t*)(ws + WS_OCAT); const float* sinks = in_ptr(7);
    for (int item = c.vcu; item < 256; item += c.G) {
        const int hq = item >> 5, t = (item & 31) * 512 + c.tid, g = hq >> 2;
        const float sl2 = alibi_slope(hq) * LOG2E;
        float q[64]; load_row64(zq + (size_t)t * NQKV + B_Q + 64 * hq, q);
        SAcc a; a.m = sinks[l * 8 + hq] * LOG2E; a.l = 1.f;
#pragma unroll
        for (int d = 0; d < 64; ++d) a.o[d] = 0.f;
        const int t0 = t - 127 < 0 ? 0 : t - 127;
        for (int tk = t0; tk <= t; ++tk) { const bf16_t* rp = zq + (size_t)tk * NQKV + 64 * g; attend_key(a, q, rp + B_K, rp + B_V, -sl2 * (float)(t - tk)); }
        store_row64_bf16(ocat + (size_t)t * KCAT + 512 + 64 * hq, a.o, 1.0f / a.l);
    }
}
__device__ __forceinline__ void ph_att_scalar_dil() {
    const Ctx c = make_ctx(); unsigned char* ws = ws_ptr();
    const bf16_t* zq = (const bf16_t*)(ws + WS_ZQ); bf16_t* cscr = (bf16_t*)(ws + WS_CSCR); float* clse = (float*)(ws + WS_CLSE);
    for (int item = c.vcu; item < 384; item += c.G) {
        const int gc = item >> 5, g = gc >> 2, cc = gc & 3, t = (item & 31) * 512 + c.tid, dil = g == 0 ? 1 : (g == 1 ? 4 : 16);
        const float sl2 = alibi_slope(8 + gc) * LOG2E;
        const int qc = C_BASE + 768 * g + 64 * cc;
        float q[64]; load_row64(zq + (size_t)t * NQKV + qc, q);
        SAcc a; a.m = -1e30f; a.l = 0.f;
#pragma unroll
        for (int d = 0; d < 64; ++d) a.o[d] = 0.f;
        for (int s = 0; s <= 128; ++s) { const int tk = t - dil * s; if (tk < 0) break; const bf16_t* rp = zq + (size_t)tk * NQKV + qc; attend_key(a, q, rp + 256, rp + 512, -sl2 * (float)(dil * s)); }
        store_row64_bf16(cscr + ((size_t)(g * S + t) * 4 + cc) * 64, a.o, 1.0f / a.l);
        clse[(size_t)(g * S + t) * 4 + cc] = a.m + __log2f(a.l);
    }
}
__device__ __forceinline__ void ph_dil_combine() {
    const Ctx c = make_ctx(); unsigned char* ws = ws_ptr();
    const bf16_t* cscr = (const bf16_t*)(ws + WS_CSCR); const float* clse = (const float*)(ws + WS_CLSE); bf16_t* ocat = (bf16_t*)(ws + WS_OCAT);
    for (int i = c.bx * NTHREADS + c.tid; i < S * 4 * 16; i += c.G * NTHREADS) {
        const int t = i >> 6, cc = (i >> 4) & 3, d4 = (i & 15) * 4;
        const float l0 = clse[(size_t)(0 * S + t) * 4 + cc], l1 = clse[(size_t)(1 * S + t) * 4 + cc], l2 = clse[(size_t)(2 * S + t) * 4 + cc];
        const float mx = fmaxf(l0, fmaxf(l1, l2)); const float e0 = fexp2(l0 - mx), e1 = fexp2(l1 - mx), e2 = fexp2(l2 - mx), inv = 1.0f / (e0 + e1 + e2);
        const u32x2 w0 = *(const u32x2*)(cscr + ((size_t)(0 * S + t) * 4 + cc) * 64 + d4), w1 = *(const u32x2*)(cscr + ((size_t)(1 * S + t) * 4 + cc) * 64 + d4), w2 = *(const u32x2*)(cscr + ((size_t)(2 * S + t) * 4 + cc) * 64 + d4);
        const f32x4 o0 = (f32x4){bflo(w0.x), bfhi(w0.x), bflo(w0.y), bfhi(w0.y)}, o1 = (f32x4){bflo(w1.x), bfhi(w1.x), bflo(w1.y), bfhi(w1.y)}, o2 = (f32x4){bflo(w2.x), bfhi(w2.x), bflo(w2.y), bfhi(w2.y)};
        const f32x4 o = (o0 * e0 + o1 * e1 + o2 * e2) * inv;
        u32x2 w; w.x = pk2(o[0], o[1]); w.y = pk2(o[2], o[3]);
        *(u32x2*)(ocat + (size_t)t * KCAT + 1024 + 64 * cc + d4) = w;
    }
}

struct Args { const float* in[17]; float* out; unsigned char* ws; int ph_lo, ph_hi; };
__global__ void __launch_bounds__(NTHREADS, 2) trunk_fwd(Args args) {
    extern __shared__ __attribute__((aligned(16))) unsigned char lds_raw[];
    LAS unsigned char* lds = (LAS unsigned char*)lds_raw;
    volatile LAS unsigned* MISC = (volatile LAS unsigned*)(lds + MISC_OFF);
    if (threadIdx.x < 64) MISC[threadIdx.x] = 0u;
    __syncthreads();
    XcdBarrier bar; bar.bar = (unsigned*)(args.ws + WS_CTL); bar.x = 0; bar.st = nullptr;
#if !MK_MULTI
    bar = xcd_barrier_post((unsigned*)(args.ws + WS_CTL), MISC + 8);
#endif
    const int lo = args.ph_lo, hi = args.ph_hi;
    int step = 0;
#define PHASE_BEGIN if (step >= lo && step < hi) {
#if MK_MULTI
#define PHASE_END } ++step;
#else
#define PHASE_END if (step + 1 < hi) xcd_barrier(bar); } ++step;
#endif
    PHASE_BEGIN ph_adaln_convert0(lds); ph_convert(lds, 0, 3); PHASE_END
    PHASE_BEGIN ph_modtables(); PHASE_END
    PHASE_BEGIN ph_norm(0, 0); PHASE_END
    for (int l = 0; l < DEPTH; ++l) {
        PHASE_BEGIN ph_inproj(lds); PHASE_END
        PHASE_BEGIN ph_kmean(); if (l + 1 < DEPTH) ph_convert(lds, l + 1, 1); PHASE_END
        PHASE_BEGIN ph_topk(lds); PHASE_END
#if ATT_SCALAR
        PHASE_BEGIN ph_att_scalar_moba(); ph_att_scalar_swa(l); ph_att_scalar_dil(); PHASE_END
        PHASE_BEGIN ph_dil_combine(); PHASE_END
#else
        PHASE_BEGIN ph_att1(lds, l); PHASE_END
        PHASE_BEGIN ph_att2(lds); ph_dil_combine(); PHASE_END
#endif
        PHASE_BEGIN ph_merge(lds); PHASE_END
        PHASE_BEGIN ph_wout(lds); PHASE_END
        PHASE_BEGIN ph_norm(1, l); PHASE_END
        PHASE_BEGIN ph_gateup(lds); PHASE_END
        PHASE_BEGIN ph_down(lds); PHASE_END
        PHASE_BEGIN ph_norm(2, l); if (l + 1 < DEPTH) ph_convert(lds, l + 1, 2); PHASE_END
    }
#undef PHASE_BEGIN
#undef PHASE_END
}
constexpr int N_STEPS = 3 + DEPTH * 11;

extern "C" void kernel_launch(void* const* d_in, const int* in_sizes, int n_in, void* d_out, int out_size, void* d_ws, size_t ws_size, hipStream_t stream) {
    static int grid = 0;
    if (grid == 0) {
        if (n_in != 17 || in_sizes[0] != S * D || out_size != S * D || ws_size < WS_END) { fprintf(stderr, "kernel_launch: unexpected shapes / workspace (%d inputs, ws %zu)\n", n_in, ws_size); grid = -1; return; }
        int dev = 0, cus = 0, per_cu = 0;
        if (hipGetDevice(&dev) != hipSuccess || hipDeviceGetAttribute(&cus, hipDeviceAttributeMultiprocessorCount, dev) != hipSuccess) { grid = -1; return; }
        if (hipFuncSetAttribute((const void*)trunk_fwd, hipFuncAttributeMaxDynamicSharedMemorySize, LDS_BYTES) != hipSuccess) { grid = -1; return; }
        if (hipOccupancyMaxActiveBlocksPerMultiprocessor(&per_cu, (const void*)trunk_fwd, NTHREADS, LDS_BYTES) != hipSuccess || per_cu < 1) { fprintf(stderr, "kernel_launch: occupancy query says %d\n", per_cu); }
        (void)hipGetLastError();
        grid = cus;
    }
    if (grid < 0) return;
    (void)hipMemsetAsync((char*)d_ws + WS_CTL, 0, CTL_ZERO_BYTES, stream);
    Args a{};
    for (int i = 0; i < 17; ++i) a.in[i] = (const float*)d_in[i];
    a.out = (float*)d_out; a.ws = (unsigned char*)d_ws;
#if MK_MULTI
#ifndef MK_MAX_STEP
#define MK_MAX_STEP N_STEPS
#endif
    for (int s = 0; s < MK_MAX_STEP; ++s) { a.ph_lo = s; a.ph_hi = s + 1; hipLaunchKernelGGL(trunk_fwd, dim3(grid), dim3(NTHREADS), LDS_BYTES, stream, a); }
#else
    a.ph_lo = 0; a.ph_hi = N_STEPS; hipLaunchKernelGGL(trunk_fwd, dim3(grid), dim3(NTHREADS), LDS_BYTES, stream, a);
#endif
}
```

```cpp
#include <hip/hip_runtime.h>
#include <cstdio>
#include <cstdint>

#ifndef DUP_MASK
#define DUP_MASK 0
#endif
#ifndef ATT_SCALAR
#define ATT_SCALAR 0
#endif
#ifndef MK_MULTI
#define MK_MULTI 0
#endif

#define GAS __attribute__((address_space(1)))
#define LAS __attribute__((address_space(3)))
typedef unsigned short bf16_t;
typedef short bf16x8 __attribute__((ext_vector_type(8)));
typedef float f32x4 __attribute__((ext_vector_type(4)));
typedef float f32x2 __attribute__((ext_vector_type(2)));
typedef unsigned u32x4 __attribute__((ext_vector_type(4)));
typedef unsigned u32x2 __attribute__((ext_vector_type(2)));

constexpr int S = 16384, D = 1024, DEPTH = 4, HD = 64;
constexpr int NQKV = 4608, NGATE = 3072, NIN = 7680, DFF = 2816, NGU = 5632, KCAT = 1280;
constexpr int A_Q = 0, A_K = 512, A_V = 1024, B_Q = 1536, B_K = 2048, B_V = 2176, C_BASE = 2304;
constexpr float LOG2E = 1.4426950408889634f, QSCALE = 0.125f * LOG2E, RMS_EPS = 1e-6f;
constexpr int NWAVES = 8, NTHREADS = 512;

constexpr size_t MiB = 1u << 20;
constexpr size_t WS_CTL = 0, CTL_ZERO_BYTES = 64 * 1024;
constexpr size_t WS_CNT = 256 * 1024;
constexpr size_t WS_MOD = 512 * 1024;
constexpr size_t WS_KMEAN = 1 * MiB;
constexpr size_t WS_SEL = 1 * MiB + 256 * 1024;
constexpr size_t WS_WIN = 2 * MiB;
constexpr size_t WS_WCAT = 17 * MiB;
constexpr size_t WS_WOUT = 20 * MiB;
constexpr size_t WS_WGU = 22 * MiB;
constexpr size_t WS_WDN = 33 * MiB;
constexpr size_t WS_U = 42 * MiB;
constexpr size_t WS_ZQ = 74 * MiB;
constexpr size_t WS_MSCR = 74 * MiB;
constexpr size_t WS_Y = 138 * MiB;
constexpr size_t WS_ACT = 74 * MiB;
constexpr size_t WS_GATES = 218 * MiB;
constexpr size_t WS_Y2 = 218 * MiB;
constexpr size_t WS_OCAT = 314 * MiB;
constexpr size_t WS_PART = 354 * MiB;
constexpr size_t WS_PARTML = 450 * MiB;
constexpr size_t WS_MERGED = 354 * MiB;
constexpr size_t WS_CSCR = 453 * MiB;
constexpr size_t WS_CLSE = 477 * MiB;
constexpr size_t WS_END = 478 * MiB;

constexpr int RING_BYTES = 131072;
constexpr int MISC_OFF = RING_BYTES;
constexpr int LDS_BYTES = 147456;

#define RLX_AGENT __ATOMIC_RELAXED, __HIP_MEMORY_SCOPE_AGENT
__device__ __forceinline__ unsigned f2bf(float f) { unsigned u = __builtin_bit_cast(unsigned, f); return (u + 0x7fffu + ((u >> 16) & 1u)) >> 16; }
__device__ __forceinline__ unsigned pk2(float lo, float hi) { return f2bf(lo) | (f2bf(hi) << 16); }
__device__ __forceinline__ float bflo(unsigned w) { return __builtin_bit_cast(float, w << 16); }
__device__ __forceinline__ float bfhi(unsigned w) { return __builtin_bit_cast(float, w & 0xffff0000u); }
__device__ __forceinline__ unsigned cvt_pk_bf16(float lo, float hi) { unsigned r; asm volatile("v_cvt_pk_bf16_f32 %0, %1, %2" : "=v"(r) : "v"(lo), "v"(hi)); return r; }
__device__ __forceinline__ float fexp2(float x) { return __builtin_amdgcn_exp2f(x); }
__device__ __forceinline__ float frcp(float x) { return __builtin_amdgcn_rcpf(x); }
__device__ __forceinline__ float wave_sum(float v) {
#pragma unroll
    for (int o = 1; o < 64; o <<= 1) v += __shfl_xor(v, o);
    return v;
}
__device__ __forceinline__ float alibi_slope(int i) { return exp2f(-8.0f * (float)(i + 1) / 28.0f); }

namespace pg8 {
constexpr int BM = 256, BK = 64, HALF = 128, HTB = HALF * BK * 2, STAGE_BYTES = 8 * HTB, NXCD = 8, WGM = 8;
__host__ __device__ __forceinline__ int lds_byte(int r, int c) { const int st = (r >> 4) * 2 + (c >> 5), rr = r & 15, cc = c & 31, ob = rr * 64 + cc * 2; return st * 1024 + (ob ^ (((ob >> 9) & 1) << 5)); }
__host__ __device__ __forceinline__ void stage_rc(int b, int& R, int& C) { const int st = b / 1024, sb = b % 1024, swz = sb ^ (((sb >> 9) & 1) << 5); R = (st >> 1) * 16 + swz / 64; C = (st & 1) * 32 + (swz % 64) / 2; }
__host__ __device__ __forceinline__ int perm32(int rho) { const int n = rho >> 4, i = rho & 15; return 8 * (i >> 2) + 4 * n + (i & 3); }

struct Unit { int pm, pn, ko, nt, seg; };
struct Gemm { const bf16_t* A; const bf16_t* Bt; int lda, ldb; };

__host__ __device__ __forceinline__ void tile_of(int wgid, int nM, int nN, int& pm, int& pn) {
    const int nwg = nM * nN;
    { const int q = nwg / NXCD, r = nwg % NXCD, xcd = wgid % NXCD, off = wgid / NXCD; wgid = (xcd < r ? xcd * (q + 1) : r * (q + 1) + (xcd - r) * q) + off; }
    const int nig = WGM * nN, gid = wgid / nig, fm = gid * WGM, gsz = (nM - fm) < WGM ? (nM - fm) : WGM;
    pm = fm + ((wgid % nig) % gsz); pn = (wgid % nig) / gsz;
}
struct StaticOrder {
    int nM, nN, nwg, G, c, nt;
    __device__ void init(int M, int N, int K, int G_, int c_) { nM = M / BM; nN = N / BM; nwg = nM * nN; G = G_; c = c_; nt = K / BK; }
    __device__ bool next(int i, Unit& u) const {
        const long L = (long)i * G + c; if (L >= nwg) return false;
        tile_of((int)L, nM, nN, u.pm, u.pn); u.ko = 0; u.nt = nt; u.seg = 0; return true;
    }
};
struct MergeOrder {
    int nM, nN, nwg, G, c;
    __device__ void init(int M, int N, int G_, int c_) { nM = M / BM; nN = N / BM; nwg = nM * nN; G = G_; c = c_; }
    __device__ bool next(int i, Unit& u) const {
        const int seg = i % 3; const long L = (long)(i / 3) * G + c; if (L >= nwg) return false;
        tile_of((int)L, nM, nN, u.pm, u.pn); u.seg = seg; u.ko = seg * 512; u.nt = seg == 2 ? 4 : 8; return true;
    }
};

__device__ __forceinline__ float sigm(float x) { return frcp(1.0f + fexp2(-LOG2E * x)); }

struct EpiInproj {
    static constexpr bool PERM = true;
    bf16_t* zq; bf16_t* gates;
    __device__ __forceinline__ void operator()(const f32x4 (&acc)[2][2][4][2], const Unit& u, int wr, int wc, int fr, int fq) const {
        const int row0 = u.pm * BM + wr * 64 + fr;
        const bool isg = u.pn >= 18;
        const bool isq = (u.pn < 2) || (u.pn == 6) || (u.pn == 7) || (u.pn == 9) || (u.pn == 12) || (u.pn == 15);
        const float sc = isq ? QSCALE : 1.0f;
        bf16_t* base = isg ? gates : zq; const int ldc = isg ? NGATE : NQKV;
        const int col0 = (isg ? (u.pn - 18) : u.pn) * BM + wc * 32 + 8 * fq;
#pragma unroll
        for (int ai = 0; ai < 2; ++ai)
#pragma unroll
            for (int m = 0; m < 4; ++m) { bf16_t* rowp = base + (size_t)(row0 + ai * HALF + m * 16) * ldc + col0;
#pragma unroll
                for (int bj = 0; bj < 2; ++bj) { f32x4 v0 = acc[ai][bj][m][0], v1 = acc[ai][bj][m][1];
                    if (isg) { v0 = (f32x4){sigm(v0[0]), sigm(v0[1]), sigm(v0[2]), sigm(v0[3])}; v1 = (f32x4){sigm(v1[0]), sigm(v1[1]), sigm(v1[2]), sigm(v1[3])}; }
                    else { v0 = v0 * sc; v1 = v1 * sc; }
                    u32x4 w; w.x = cvt_pk_bf16(v0[0], v0[1]); w.y = cvt_pk_bf16(v0[2], v0[3]); w.z = cvt_pk_bf16(v1[0], v1[1]); w.w = cvt_pk_bf16(v1[2], v1[3]);
                    *(GAS u32x4*)(rowp + bj * HALF) = w; } }
    }
};
struct EpiF32 {
    static constexpr bool PERM = false;
    float* C; int ldc;
    __device__ __forceinline__ void operator()(const f32x4 (&acc)[2][2][4][2], const Unit& u, int wr, int wc, int fr, int fq) const {
        const int row0 = u.pm * BM + wr * 64 + fr, col0 = u.pn * BM + wc * 32 + 4 * fq;
#pragma unroll
        for (int ai = 0; ai < 2; ++ai)
#pragma unroll
            for (int m = 0; m < 4; ++m) { float* rowp = C + (size_t)(row0 + ai * HALF + m * 16) * ldc + col0;
#pragma unroll
                for (int bj = 0; bj < 2; ++bj)
#pragma unroll
                    for (int n = 0; n < 2; ++n) *(GAS f32x4*)(rowp + bj * HALF + n * 16) = acc[ai][bj][m][n]; }
    }
};
struct EpiSwiglu {
    static constexpr bool PERM = true;
    bf16_t* act;
    __device__ __forceinline__ void operator()(const f32x4 (&acc)[2][2][4][2], const Unit& u, int wr, int wc, int fr, int fq) const {
        const int row0 = u.pm * BM + wr * 64 + fr, col0 = u.pn * HALF + wc * 32 + 8 * fq;
#pragma unroll
        for (int ai = 0; ai < 2; ++ai)
#pragma unroll
            for (int m = 0; m < 4; ++m) { bf16_t* rowp = act + (size_t)(row0 + ai * HALF + m * 16) * DFF + col0;
                float r[8];
#pragma unroll
                for (int n = 0; n < 2; ++n)
#pragma unroll
                    for (int i = 0; i < 4; ++i) { const float g = acc[ai][0][m][n][i], up = acc[ai][1][m][n][i]; r[n * 4 + i] = g * sigm(g) * up; }
                u32x4 w; w.x = cvt_pk_bf16(r[0], r[1]); w.y = cvt_pk_bf16(r[2], r[3]); w.z = cvt_pk_bf16(r[4], r[5]); w.w = cvt_pk_bf16(r[6], r[7]);
                *(GAS u32x4*)rowp = w; }
    }
};
struct EpiMerge {
    static constexpr bool PERM = true;
    const bf16_t* gates; float* scr; bf16_t* merged;
    __device__ __forceinline__ void operator()(const f32x4 (&acc)[2][2][4][2], const Unit& u, int wr, int wc, int fr, int fq) const {
        const int row0 = u.pm * BM + wr * 64 + fr, col0 = u.pn * BM + wc * 32 + 8 * fq;
#pragma unroll
        for (int ai = 0; ai < 2; ++ai)
#pragma unroll
            for (int m = 0; m < 4; ++m) { const size_t row = (size_t)(row0 + ai * HALF + m * 16);
#pragma unroll
                for (int bj = 0; bj < 2; ++bj) { const int col = col0 + bj * HALF;
                    const u32x4 gw = *(const GAS u32x4*)(gates + row * NGATE + u.seg * D + col);
                    f32x4 v0 = acc[ai][bj][m][0], v1 = acc[ai][bj][m][1];
                    v0 = v0 * (f32x4){bflo(gw.x), bfhi(gw.x), bflo(gw.y), bfhi(gw.y)}; v1 = v1 * (f32x4){bflo(gw.z), bfhi(gw.z), bflo(gw.w), bfhi(gw.w)};
                    float* sp = scr + row * D + col;
                    if (u.seg > 0) { v0 = v0 + *(const GAS f32x4*)sp; v1 = v1 + *(const GAS f32x4*)(sp + 4); }
                    if (u.seg < 2) { *(GAS f32x4*)sp = v0; *(GAS f32x4*)(sp + 4) = v1; }
                    else { u32x4 w; w.x = cvt_pk_bf16(v0[0], v0[1]); w.y = cvt_pk_bf16(v0[2], v0[3]); w.z = cvt_pk_bf16(v1[0], v1[1]); w.w = cvt_pk_bf16(v1[2], v1[3]);
                        *(GAS u32x4*)(merged + row * D + col) = w; } } }
    }
};

template <class Epi, class Sched, bool ALIGN_EPI>
__device__ __forceinline__ void gemm_phase(LAS unsigned char* lds, const Gemm g, const Sched& S, const Epi& E) {
    int tid = threadIdx.x; asm volatile("" : "+v"(tid));
    const int wid = __builtin_amdgcn_readfirstlane(tid >> 6), lane = tid & 63, wr = wid >> 2, wc = wid & 3, fr = lane & 15, fq = lane >> 4;
    unsigned voffA[2], voffB[2];
#pragma unroll
    for (int i = 0; i < 2; ++i) { int R, C; stage_rc(tid * 16 + i * 8192, R, C); const int Rb = Epi::PERM ? ((R & ~31) + perm32(R & 31)) : R;
        voffA[i] = (unsigned)(R * g.lda + C) * 2u; voffB[i] = (unsigned)(Rb * g.ldb + C) * 2u; }
    const size_t kstep = (size_t)(BK * 2);
    const size_t hstepA = (size_t)HALF * g.lda * 2, hstepB = (size_t)HALF * g.ldb * 2;
    const size_t tstepA = 2 * hstepA, tstepB = 2 * hstepB;
    const unsigned ldsw = (unsigned)wid * 1024u;
    const int aoff = lds_byte(wr * 64 + fr, fq * 8), boff = lds_byte(wc * 32 + fr, fq * 8);
#define PG8_SA(b, h) (((b) * 2 + (h)) * HTB)
#define PG8_SB(b, h) ((4 + (b) * 2 + (h)) * HTB)
#define PG8_STAGE(bufoff, gbase, voff) do { _Pragma("unroll") for (int _i = 0; _i < 2; ++_i) \
        __builtin_amdgcn_global_load_lds((const unsigned*)((const char*)(gbase) + (voff)[_i]), (LAS unsigned*)(lds + (bufoff) + ldsw + _i * 8192), 16, 0, 0); } while (0)
#define PG8_LDA(dst, b, h) do { _Pragma("unroll") for (int m = 0; m < 4; ++m) _Pragma("unroll") for (int k = 0; k < 2; ++k) dst[m][k] = *(const LAS bf16x8*)(lds + PG8_SA(b, h) + aoff + m * 2048 + k * 1024); } while (0)
#define PG8_LDB(dst, b, h) do { _Pragma("unroll") for (int n = 0; n < 2; ++n) _Pragma("unroll") for (int k = 0; k < 2; ++k) dst[n][k] = *(const LAS bf16x8*)(lds + PG8_SB(b, h) + boff + n * 2048 + k * 1024); } while (0)
#define PG8_MMA(ai, bj, At, Bt) do { __builtin_amdgcn_s_setprio(1); _Pragma("unroll") for (int m = 0; m < 4; ++m) _Pragma("unroll") for (int n = 0; n < 2; ++n) _Pragma("unroll") for (int k = 0; k < 2; ++k) \
        acc[ai][bj][m][n] = __builtin_amdgcn_mfma_f32_16x16x32_bf16(Bt[n][k], At[m][k], acc[ai][bj][m][n], 0, 0, 0); __builtin_amdgcn_s_setprio(0); } while (0)
#define PG8_WAIT_V(n) asm volatile("s_waitcnt vmcnt(" #n ")" ::: "memory")
#define PG8_WAIT_L(n) asm volatile("s_waitcnt lgkmcnt(" #n ")" ::: "memory")
#define PG8_BAR __builtin_amdgcn_s_barrier()
#define PG8_SCHED __builtin_amdgcn_sched_barrier(0)
    Unit cur, nxt; int ui = 0;
    if (!S.next(0, cur)) return;
    f32x4 acc[2][2][4][2];
#pragma unroll
    for (int a = 0; a < 2; ++a)
#pragma unroll
        for (int b = 0; b < 2; ++b)
#pragma unroll
            for (int m = 0; m < 4; ++m)
#pragma unroll
                for (int n = 0; n < 2; ++n) acc[a][b][m][n] = (f32x4){0.f, 0.f, 0.f, 0.f};
    bf16x8 At[4][2], B0[2][2], B1[2][2];
    const char* cA = (const char*)g.A + (size_t)cur.pm * tstepA + (size_t)cur.ko * 2; const char* cB = (const char*)g.Bt + (size_t)cur.pn * tstepB + (size_t)cur.ko * 2;
    PG8_STAGE(PG8_SB(0, 0), cB, voffB); PG8_STAGE(PG8_SB(0, 1), cB + hstepB, voffB); PG8_STAGE(PG8_SA(0, 0), cA, voffA); PG8_STAGE(PG8_SA(0, 1), cA + hstepA, voffA);
    if (wr == 1) PG8_BAR;
    PG8_WAIT_V(2); PG8_BAR;
    PG8_STAGE(PG8_SB(1, 0), cB + kstep, voffB); PG8_STAGE(PG8_SA(1, 0), cA + kstep, voffA); PG8_STAGE(PG8_SB(1, 1), cB + hstepB + kstep, voffB);
    PG8_WAIT_V(6); PG8_BAR;
    for (;;) {
        const bool has_next = S.next(ui + 1, nxt);
        const char* nA = has_next ? (const char*)g.A + (size_t)nxt.pm * tstepA + (size_t)nxt.ko * 2 : cA; const char* nB = has_next ? (const char*)g.Bt + (size_t)nxt.pn * tstepB + (size_t)nxt.ko * 2 : cB;
        const int nt = cur.nt;
        for (int t = 0; t < nt; t += 2) {
            const bool last = (t == nt - 2);
            const char* a1 = cA + (size_t)(t + 1) * kstep;
            const char* a2 = last ? nA : cA + (size_t)(t + 2) * kstep; const char* b2 = last ? nB : cB + (size_t)(t + 2) * kstep;
            const char* a3 = a2 + kstep; const char* b3 = b2 + kstep;
            PG8_LDB(B0, 0, 0); PG8_LDB(B1, 0, 1); PG8_SCHED; PG8_LDA(At, 0, 0); PG8_STAGE(PG8_SA(1, 1), a1 + hstepA, voffA);
            PG8_WAIT_V(8); PG8_WAIT_L(0); PG8_BAR; PG8_MMA(0, 0, At, B0); PG8_MMA(0, 1, At, B1); PG8_BAR; PG8_SCHED;
            PG8_LDA(At, 0, 1); PG8_STAGE(PG8_SB(0, 0), b2, voffB); PG8_STAGE(PG8_SB(0, 1), b2 + hstepB, voffB); PG8_STAGE(PG8_SA(0, 0), a2, voffA);
            PG8_WAIT_V(8); PG8_WAIT_L(0); PG8_BAR; PG8_MMA(1, 0, At, B0); PG8_MMA(1, 1, At, B1); PG8_BAR; PG8_SCHED;
            PG8_LDB(B0, 1, 0); PG8_LDB(B1, 1, 1); PG8_SCHED; PG8_LDA(At, 1, 0); PG8_STAGE(PG8_SA(0, 1), a2 + hstepA, voffA);
            PG8_WAIT_V(8); PG8_WAIT_L(0); PG8_BAR; PG8_MMA(0, 0, At, B0); PG8_MMA(0, 1, At, B1); PG8_BAR; PG8_SCHED;
            PG8_LDA(At, 1, 1); PG8_STAGE(PG8_SB(1, 0), b3, voffB); PG8_STAGE(PG8_SB(1, 1), b3 + hstepB, voffB); PG8_STAGE(PG8_SA(1, 0), a3, voffA);
            PG8_WAIT_V(8); PG8_WAIT_L(0); PG8_BAR; PG8_MMA(1, 0, At, B0); PG8_MMA(1, 1, At, B1); PG8_BAR; PG8_SCHED;
        }
        if constexpr (ALIGN_EPI) { if (wr == 0) PG8_BAR; }
        E(acc, cur, wr, wc, fr, fq);
        if (!has_next) break;
#pragma unroll
        for (int a = 0; a < 2; ++a)
#pragma unroll
            for (int b = 0; b < 2; ++b)
#pragma unroll
                for (int m = 0; m < 4; ++m)
#pragma unroll
                    for (int n = 0; n < 2; ++n) acc[a][b][m][n] = (f32x4){0.f, 0.f, 0.f, 0.f};
        cur = nxt; cA = nA; cB = nB; ++ui;
        if constexpr (ALIGN_EPI) { if (wr == 1) PG8_BAR; }
    }
    PG8_WAIT_V(0);
    if constexpr (!ALIGN_EPI) { if (wr == 0) PG8_BAR; }
    PG8_BAR;
#undef PG8_SA
#undef PG8_SB
#undef PG8_STAGE
#undef PG8_LDA
#undef PG8_LDB
#undef PG8_MMA
#undef PG8_WAIT_V
#undef PG8_WAIT_L
#undef PG8_BAR
#undef PG8_SCHED
}
}

#define XB_TMO      128
#define XB_XCNT(j)  (256  + 64 * (j))
#define XB_XSUB(j)  (1280 + 64 * (j))
#define XB_XGEN(j)  (2304 + 64 * (j))
#define XB_TOP      3328
#define XB_TOPGEN   3392
#define XCD_BAR_WORDS 3456
#define XB_SPIN_CAP (1u << 18)
__device__ __forceinline__ unsigned xb_ld(unsigned* p)              { return __hip_atomic_load(p, __ATOMIC_RELAXED, __HIP_MEMORY_SCOPE_AGENT); }
__device__ __forceinline__ unsigned xb_add(unsigned* p, unsigned v) { return __hip_atomic_fetch_add(p, v, __ATOMIC_RELAXED, __HIP_MEMORY_SCOPE_AGENT); }
__device__ __forceinline__ unsigned xb_xcc_id() { return (unsigned)__builtin_amdgcn_s_getreg((3 << 11) | 20) & 0xFu; }
#define XB_SPIN(cond, bar) do { unsigned _sp = 0; while (cond) { __builtin_amdgcn_s_sleep(1); \
    if ((++_sp & 255u) == 0u) { if (xb_ld(&(bar)[XB_TMO])) break; if (_sp > XB_SPIN_CAP) { atomicAdd(&(bar)[XB_TMO], 1u); break; } } } } while (0)
struct XcdBarrier { unsigned* bar; unsigned x; volatile LAS unsigned* st; };
__device__ __forceinline__ XcdBarrier xcd_barrier_post(unsigned* bar, volatile LAS unsigned* st) {
    XcdBarrier b; b.bar = bar; b.x = xb_xcc_id(); b.st = st;
    if (threadIdx.x == 0) (void)xb_add(&bar[XB_XCNT(b.x)], 1u);
    return b;
}
__device__ __forceinline__ void xcd_barrier_complete(unsigned* bar, unsigned x, unsigned& nloc, unsigned& nx) {
    const unsigned G = gridDim.x * gridDim.y * gridDim.z;
    unsigned sum, cnt, mine, sp = 0u;
    for (;;) {
        sum = 0u; cnt = 0u; mine = 0u;
#pragma unroll
        for (unsigned j = 0; j < 16; ++j) { const unsigned c = xb_ld(&bar[XB_XCNT(j)]); sum += c; cnt += (c > 0u) ? 1u : 0u; mine = (j == x) ? c : mine; }
        if (sum == G) break;
        __builtin_amdgcn_s_sleep(1);
        if ((++sp & 255u) == 0u) { if (xb_ld(&bar[XB_TMO])) break; if (sp > XB_SPIN_CAP) { atomicAdd(&bar[XB_TMO], 1u); break; } }
    }
    nloc = mine > 0u ? mine : 1u; nx = cnt > 0u ? cnt : 1u;
}
__device__ __forceinline__ void xcd_barrier(const XcdBarrier& b) {
    asm volatile("s_waitcnt vmcnt(0)" ::: "memory");
    __syncthreads();
    if (threadIdx.x == 0) {
        unsigned* bar = b.bar;
        __builtin_amdgcn_s_waitcnt(0);
        unsigned nloc = b.st[0], nx = b.st[1];
        if (nloc == 0u) { xcd_barrier_complete(bar, b.x, nloc, nx); b.st[0] = nloc; b.st[1] = nx; }
        const unsigned old = xb_add(&bar[XB_XSUB(b.x)], 1u);
        const unsigned gen = old / nloc;
        if (old + 1u == (gen + 1u) * nloc) {
            __builtin_amdgcn_fence(__ATOMIC_RELEASE, "agent");
            asm volatile("s_waitcnt vmcnt(0)" ::: "memory");
            const unsigned og = xb_add(&bar[XB_TOP], 1u);
            const unsigned tg = og / nx;
            if (og + 1u == (tg + 1u) * nx) xb_add(&bar[XB_TOPGEN], 1u);
            else XB_SPIN(xb_ld(&bar[XB_TOPGEN]) == tg, bar);
            __builtin_amdgcn_fence(__ATOMIC_ACQUIRE, "agent");
            xb_add(&bar[XB_XGEN(b.x)], 1u);
            asm volatile("s_waitcnt vmcnt(0)" ::: "memory");
        } else {
            XB_SPIN(xb_ld(&bar[XB_XGEN(b.x)]) == gen, bar);
            __builtin_amdgcn_fence(__ATOMIC_ACQUIRE, "agent");
            asm volatile("s_waitcnt vmcnt(0)" ::: "memory");
        }
    }
    __syncthreads();
}


__device__ __forceinline__ void transpose_item(const float* W, int N, bf16_t* WT, int ldt, int kofs, int k0, int n0, int drow0, LAS float* scr, int lane) {
    { f32x4 v[8];
#pragma unroll
      for (int i = 0; i < 8; ++i) v[i] = *(const GAS f32x4*)(W + (size_t)(k0 + (lane >> 3) + 8 * i) * N + n0 + 4 * (lane & 7));
#pragma unroll
      for (int i = 0; i < 8; ++i)
#pragma unroll
          for (int e = 0; e < 4; ++e) scr[((lane >> 3) + 8 * i) * 33 + 4 * (lane & 7) + e] = v[i][e]; }
    asm volatile("s_waitcnt lgkmcnt(0)" ::: "memory");
    const int c = lane & 7;
#pragma unroll
    for (int j = 0; j < 4; ++j) { const int n = (lane >> 3) + 8 * j; const LAS float* s = scr + (8 * c) * 33 + n;
        u32x4 o; o.x = pk2(s[0 * 33], s[1 * 33]); o.y = pk2(s[2 * 33], s[3 * 33]); o.z = pk2(s[4 * 33], s[5 * 33]); o.w = pk2(s[6 * 33], s[7 * 33]);
        *(GAS u32x4*)(WT + (size_t)(drow0 + n) * ldt + kofs + k0 + 8 * c) = o; }
    asm volatile("s_waitcnt lgkmcnt(0)" ::: "memory");
}
__device__ __forceinline__ void convert_matrix(const float* W, int K, int N, bf16_t* WT, int ldt, int kofs, int mode, LAS float* scr, int gw, int ngw, int lane, int& first) {
    const int nblk = N / 32, nitems = (K / 64) * nblk;
    int it = gw - (first % ngw); if (it < 0) it += ngw;
    for (; it < nitems; it += ngw) {
        const int kb = it / nblk, nb = it % nblk, n0 = 32 * nb;
        const int drow0 = mode == 0 ? n0 : (256 * (n0 >> 7) + (n0 & 127) + (mode == 2 ? 128 : 0));
        transpose_item(W, N, WT, ldt, kofs, 64 * kb, n0, drow0, scr, lane);
    }
    first += nitems;
}

__device__ __forceinline__ void norm_rows(const float* y, const float* hin, float* hout, const float* Gv, const float* Av, const float* Bv, bf16_t* ub, int gw, int ngw, int lane) {
    f32x4 G[4], A[4], B[4];
#pragma unroll
    for (int j = 0; j < 4; ++j) {
        G[j] = y ? *(const GAS f32x4*)(Gv + 4 * lane + 256 * j) : (f32x4){0.f, 0.f, 0.f, 0.f};
        A[j] = ub ? *(const GAS f32x4*)(Av + 4 * lane + 256 * j) : (f32x4){0.f, 0.f, 0.f, 0.f};
        B[j] = ub ? *(const GAS f32x4*)(Bv + 4 * lane + 256 * j) : (f32x4){0.f, 0.f, 0.f, 0.f};
    }
    for (int row = gw; row < S; row += ngw) {
        f32x4 h[4];
#pragma unroll
        for (int j = 0; j < 4; ++j) h[j] = *(const GAS f32x4*)(hin + (size_t)row * D + 4 * lane + 256 * j);
        if (y) {
            f32x4 v[4]; float s = 0.f;
#pragma unroll
            for (int j = 0; j < 4; ++j) { v[j] = *(const GAS f32x4*)(y + (size_t)row * D + 4 * lane + 256 * j); s += (v[j][0] * v[j][0] + v[j][1] * v[j][1]) + (v[j][2] * v[j][2] + v[j][3] * v[j][3]); }
            const float r = 1.0f / sqrtf(wave_sum(s) * (1.0f / D) + RMS_EPS);
#pragma unroll
            for (int j = 0; j < 4; ++j) { h[j] = h[j] + G[j] * (v[j] * r); *(GAS f32x4*)(hout + (size_t)row * D + 4 * lane + 256 * j) = h[j]; }
        }
        if (ub) {
            float s = 0.f;
#pragma unroll
            for (int j = 0; j < 4; ++j) s += (h[j][0] * h[j][0] + h[j][1] * h[j][1]) + (h[j][2] * h[j][2] + h[j][3] * h[j][3]);
            const float r = 1.0f / sqrtf(wave_sum(s) * (1.0f / D) + RMS_EPS);
#pragma unroll
            for (int j = 0; j < 4; ++j) { const f32x4 o = (h[j] * r) * A[j] + B[j]; u32x2 w; w.x = pk2(o[0], o[1]); w.y = pk2(o[2], o[3]);
                *(GAS u32x2*)(ub + (size_t)row * D + 4 * lane + 256 * j) = w; }
        }
    }
}

struct SAcc { float m, l; float o[64]; };
__device__ __forceinline__ void load_row64(const bf16_t* p, float (&q)[64]) {
#pragma unroll
    for (int c = 0; c < 8; ++c) { const u32x4 w = *(const GAS u32x4*)(p + 8 * c);
        q[8 * c + 0] = bflo(w.x); q[8 * c + 1] = bfhi(w.x); q[8 * c + 2] = bflo(w.y); q[8 * c + 3] = bfhi(w.y);
        q[8 * c + 4] = bflo(w.z); q[8 * c + 5] = bfhi(w.z); q[8 * c + 6] = bflo(w.w); q[8 * c + 7] = bfhi(w.w); }
}
__device__ __forceinline__ void attend_key(SAcc& a, const float (&q)[64], const bf16_t* kp, const bf16_t* vp, float bias) {
    float s0 = 0.f, s1 = 0.f;
#pragma unroll
    for (int c = 0; c < 8; ++c) { const u32x4 w = *(const GAS u32x4*)(kp + 8 * c);
        s0 += q[8 * c + 0] * bflo(w.x); s1 += q[8 * c + 1] * bfhi(w.x); s0 += q[8 * c + 2] * bflo(w.y); s1 += q[8 * c + 3] * bfhi(w.y);
        s0 += q[8 * c + 4] * bflo(w.z); s1 += q[8 * c + 5] * bfhi(w.z); s0 += q[8 * c + 6] * bflo(w.w); s1 += q[8 * c + 7] * bfhi(w.w); }
    const float s = s0 + s1 + bias;
    const float mn = fmaxf(a.m, s), al = fexp2(a.m - mn), p = fexp2(s - mn);
    a.m = mn; a.l = a.l * al + p;
#pragma unroll
    for (int c = 0; c < 8; ++c) { const u32x4 w = *(const GAS u32x4*)(vp + 8 * c);
        a.o[8 * c + 0] = a.o[8 * c + 0] * al + p * bflo(w.x); a.o[8 * c + 1] = a.o[8 * c + 1] * al + p * bfhi(w.x);
        a.o[8 * c + 2] = a.o[8 * c + 2] * al + p * bflo(w.y); a.o[8 * c + 3] = a.o[8 * c + 3] * al + p * bfhi(w.y);
        a.o[8 * c + 4] = a.o[8 * c + 4] * al + p * bflo(w.z); a.o[8 * c + 5] = a.o[8 * c + 5] * al + p * bfhi(w.z);
        a.o[8 * c + 6] = a.o[8 * c + 6] * al + p * bflo(w.w); a.o[8 * c + 7] = a.o[8 * c + 7] * al + p * bfhi(w.w); }
}
__device__ __forceinline__ void store_row64_bf16(bf16_t* p, const float (&o)[64], float sc) {
#pragma unroll
    for (int c = 0; c < 8; ++c) { u32x4 w; w.x = pk2(o[8 * c] * sc, o[8 * c + 1] * sc); w.y = pk2(o[8 * c + 2] * sc, o[8 * c + 3] * sc); w.z = pk2(o[8 * c + 4] * sc, o[8 * c + 5] * sc); w.w = pk2(o[8 * c + 6] * sc, o[8 * c + 7] * sc);
        *(GAS u32x4*)(p + 8 * c) = w; }
}

typedef __attribute__((address_space(4))) const unsigned long long* karg_t;
#if defined(__HIP_DEVICE_COMPILE__)
#define ASSUME_GLOBAL(p) __builtin_assume(!__builtin_amdgcn_is_shared((const void*)(p)) && !__builtin_amdgcn_is_private((const void*)(p)))
#else
#define ASSUME_GLOBAL(p) ((void)0)
#endif
__device__ __forceinline__ const float* in_ptr(int i) { int off = i; asm volatile("" : "+s"(off)); karg_t k = (karg_t)__builtin_amdgcn_kernarg_segment_ptr(); const float* p = (const float*)k[off]; ASSUME_GLOBAL(p); return p; }
__device__ __forceinline__ float* out_ptr() { int off = 17; asm volatile("" : "+s"(off)); karg_t k = (karg_t)__builtin_amdgcn_kernarg_segment_ptr(); float* p = (float*)k[off]; ASSUME_GLOBAL(p); return p; }
__device__ __forceinline__ unsigned char* ws_ptr() { int off = 18; asm volatile("" : "+s"(off)); karg_t k = (karg_t)__builtin_amdgcn_kernarg_segment_ptr(); unsigned char* p = (unsigned char*)k[off]; ASSUME_GLOBAL(p); return p; }
struct Ctx { int tid, lane, wave, G, bx, vcu, gw, ngw; };
__device__ __forceinline__ Ctx make_ctx() {
    Ctx c; int t = threadIdx.x; asm volatile("" : "+v"(t)); c.tid = t; c.lane = t & 63; c.wave = __builtin_amdgcn_readfirstlane(t >> 6);
    int g = gridDim.x, b = blockIdx.x; asm volatile("" : "+s"(g), "+s"(b)); c.G = g; c.bx = b;
    c.vcu = (g % 8 == 0) ? (b % 8) * (g / 8) + b / 8 : b; c.gw = c.vcu * NWAVES + c.wave; c.ngw = g * NWAVES; return c;
}


typedef float f32x16 __attribute__((ext_vector_type(16)));
typedef short v4i16 __attribute__((ext_vector_type(4)));
constexpr int ATT_K_OFF = 0, ATT_V_OFF = 49152, ATT_MISC_OFF = 98304;
struct AttLane { int r32, hi; unsigned ka[4]; unsigned vb[2]; };
__device__ __forceinline__ AttLane att_lane(int lane) {
    AttLane L; L.r32 = lane & 31; L.hi = lane >> 5;
    const int x = (L.r32 >> 1) & 7;
#pragma unroll
    for (int s = 0; s < 4; ++s) L.ka[s] = (unsigned)(L.r32 * 128 + (((2 * s + L.hi) ^ x) * 16));
    const int i = lane & 15, q_ = i >> 2, p_ = i & 3, gb = (lane >> 4) & 1;
    const unsigned vbase = (unsigned)((4 * L.hi + q_) * 128 + ((4 * (q_ >> 1) + 2 * gb + (p_ >> 1)) * 16) + 8 * (p_ & 1));
    L.vb[0] = vbase; L.vb[1] = vbase ^ 64u; return L;
}
__device__ __forceinline__ float half_max(float v) { auto rr = __builtin_amdgcn_permlane32_swap(__float_as_uint(v), __float_as_uint(v), false, false); return fmaxf(__uint_as_float(rr[0]), __uint_as_float(rr[1])); }
__device__ __forceinline__ float half_sum(float v) { auto rr = __builtin_amdgcn_permlane32_swap(__float_as_uint(v), __float_as_uint(v), false, false); return __uint_as_float(rr[0]) + __uint_as_float(rr[1]); }
__device__ __forceinline__ v4i16 lds_tr(LAS const unsigned char* p) { return __builtin_amdgcn_ds_read_tr16_b64_v4i16((LAS v4i16*)p); }
struct QState { float m, l; f32x16 o0, o1; };
template <int VSWZ> __device__ __forceinline__ void stage_rows(LAS unsigned char* dst, const bf16_t* zq, int col, long tok0, int tokstride, int nrows, int tid) {
    for (int i = tid; i < nrows * 8; i += NTHREADS) { const int r = i >> 3, ch = i & 7; const long tok = tok0 + (long)r * tokstride;
        u32x4 v = (u32x4){0u, 0u, 0u, 0u}; if (tok >= 0) v = *(const GAS u32x4*)(zq + (size_t)tok * NQKV + col + 8 * ch);
        const int cs = VSWZ ? (ch ^ (((r >> 1) & 1) << 2)) : (ch ^ ((r >> 1) & 7));
        *(LAS u32x4*)(dst + r * 128 + cs * 16) = v; }
}
template <bool MASK> __device__ __forceinline__ void att_tile(QState& st, const bf16x8 (&qf)[4], LAS const unsigned char* Kl, LAS const unsigned char* Vl, const AttLane& L, int kt,
                                                               float slope2d, int qpos, int dlo, int dhi, const f32x16& B0) {
    LAS const unsigned char* kp = Kl + kt * 4096;
    f32x16 p = B0;
#pragma unroll
    for (int s = 0; s < 4; ++s) { const bf16x8 kf = *(LAS const bf16x8*)(kp + L.ka[s]); p = __builtin_amdgcn_mfma_f32_32x32x16_bf16(kf, qf[s], p, 0, 0, 0); }
    const float ct = slope2d * (float)(32 * kt - qpos);
    if (MASK) { const int Dt = qpos - 32 * kt - 4 * L.hi;
#pragma unroll
        for (int r = 0; r < 16; ++r) { const int dist = Dt - ((r & 3) + 8 * (r >> 2)); p[r] = (dist >= dlo && dist <= dhi) ? p[r] : -INFINITY; } }
    float mt = fmaxf(p[0], p[1]);
#pragma unroll
    for (int r = 2; r < 16; ++r) mt = fmaxf(mt, p[r]);
    mt = half_max(mt) + ct;
    const float mn = fmaxf(st.m, mt), alpha = fexp2(st.m - mn), cm = ct - mn; st.m = mn;
    float rs = 0.f;
#pragma unroll
    for (int r = 0; r < 16; ++r) { p[r] = fexp2(p[r] + cm); rs += p[r]; }
    st.l = st.l * alpha + rs;
    st.o0 = st.o0 * alpha; st.o1 = st.o1 * alpha;
    u32x4 w0, w1;
    w0.x = cvt_pk_bf16(p[0], p[1]); w0.y = cvt_pk_bf16(p[2], p[3]); w0.z = cvt_pk_bf16(p[4], p[5]); w0.w = cvt_pk_bf16(p[6], p[7]);
    w1.x = cvt_pk_bf16(p[8], p[9]); w1.y = cvt_pk_bf16(p[10], p[11]); w1.z = cvt_pk_bf16(p[12], p[13]); w1.w = cvt_pk_bf16(p[14], p[15]);
    const bf16x8 pk0 = __builtin_bit_cast(bf16x8, w0), pk1 = __builtin_bit_cast(bf16x8, w1);
    LAS const unsigned char* vp = Vl + kt * 4096;
#define ATT_VF(d0, s2) ({ const v4i16 a_ = lds_tr(vp + L.vb[d0] + (s2) * 2048), b_ = lds_tr(vp + L.vb[d0] + (s2) * 2048 + 1024); (bf16x8){a_[0], a_[1], a_[2], a_[3], b_[0], b_[1], b_[2], b_[3]}; })
    { const bf16x8 v00 = ATT_VF(0, 0), v01 = ATT_VF(0, 1), v10 = ATT_VF(1, 0), v11 = ATT_VF(1, 1);
      st.o0 = __builtin_amdgcn_mfma_f32_32x32x16_bf16(v00, pk0, st.o0, 0, 0, 0); st.o1 = __builtin_amdgcn_mfma_f32_32x32x16_bf16(v10, pk0, st.o1, 0, 0, 0);
      st.o0 = __builtin_amdgcn_mfma_f32_32x32x16_bf16(v01, pk1, st.o0, 0, 0, 0); st.o1 = __builtin_amdgcn_mfma_f32_32x32x16_bf16(v11, pk1, st.o1, 0, 0, 0); }
#undef ATT_VF
}
__device__ __forceinline__ void att_init(QState& st, f32x16& B0, float slope2d, int hi) {
    st.m = -1e30f; st.l = 0.f;
#pragma unroll
    for (int r = 0; r < 16; ++r) { st.o0[r] = 0.f; st.o1[r] = 0.f; B0[r] = slope2d * (float)((r & 3) + 8 * (r >> 2) + 4 * hi); }
}
__device__ __forceinline__ void load_qf(bf16x8 (&qf)[4], const bf16_t* qrow, int hi) {
#pragma unroll
    for (int s = 0; s < 4; ++s) qf[s] = *(const GAS bf16x8*)(qrow + 16 * s + 8 * hi);
}
__device__ __forceinline__ void store_o_bf16(bf16_t* orow, const QState& st, float sc, int hi) {
#pragma unroll
    for (int g4 = 0; g4 < 4; ++g4) {
        u32x2 a, b; a.x = cvt_pk_bf16(st.o0[4 * g4] * sc, st.o0[4 * g4 + 1] * sc); a.y = cvt_pk_bf16(st.o0[4 * g4 + 2] * sc, st.o0[4 * g4 + 3] * sc);
        b.x = cvt_pk_bf16(st.o1[4 * g4] * sc, st.o1[4 * g4 + 1] * sc); b.y = cvt_pk_bf16(st.o1[4 * g4 + 2] * sc, st.o1[4 * g4 + 3] * sc);
        *(GAS u32x2*)(orow + 8 * g4 + 4 * hi) = a; *(GAS u32x2*)(orow + 32 + 8 * g4 + 4 * hi) = b; }
}
__device__ __forceinline__ void att_unit_windowed(LAS unsigned char* lds, const Ctx& c, unsigned char* ws, int wu, int layer) {
    const bf16_t* zq = (const bf16_t*)(ws + WS_ZQ);
    int qcol, kcol, vcol, dil, res, np, max_steps, slope_i, kind, g = 0, cc = 0, hq = 0;
    if (wu < 512) { kind = 0; hq = wu >> 6; np = wu & 63; qcol = B_Q + 64 * hq; kcol = B_K + 64 * (hq >> 2); vcol = B_V + 64 * (hq >> 2); dil = 1; res = 0; max_steps = 127; slope_i = hq; }
    else { kind = 1; const int x = wu - 512, gc = x >> 6, y = x & 63; g = gc >> 2; cc = gc & 3; dil = g == 0 ? 1 : (g == 1 ? 4 : 16); const int per = 64 / dil; res = y / per; np = y % per;
        qcol = C_BASE + 768 * g + 64 * cc; kcol = qcol + 256; vcol = qcol + 512; max_steps = 128; slope_i = 8 + gc; }
    LAS unsigned char* Kl = lds + ATT_K_OFF; LAS unsigned char* Vl = lds + ATT_V_OFF;
    const long tok0 = (long)(256 * np - 128) * dil + res;
    __syncthreads();
    stage_rows<0>(Kl, zq, kcol, tok0, dil, 384, c.tid); stage_rows<1>(Vl, zq, vcol, tok0, dil, 384, c.tid);
    __syncthreads();
    const AttLane L = att_lane(c.lane);
    const int w = c.wave, qi = 32 * w + L.r32, t = (256 * np + qi) * dil + res, qpos = 128 + qi;
    bf16x8 qf[4]; load_qf(qf, zq + (size_t)t * NQKV + qcol, L.hi);
    const float slope2d = alibi_slope(slope_i) * LOG2E * (float)dil;
    QState st; f32x16 B0; att_init(st, B0, slope2d, L.hi);
    const int dhi = (np == 0 && qi < max_steps) ? qi : max_steps;
    if (np == 0) {
#pragma unroll 1
        for (int kt = w; kt < w + 5; ++kt) att_tile<true>(st, qf, Kl, Vl, L, kt, slope2d, qpos, 0, dhi, B0);
    } else {
        att_tile<true>(st, qf, Kl, Vl, L, w, slope2d, qpos, 0, dhi, B0);
#pragma unroll 1
        for (int kt = w + 1; kt < w + 4; ++kt) att_tile<false>(st, qf, Kl, Vl, L, kt, slope2d, qpos, 0, dhi, B0);
        att_tile<true>(st, qf, Kl, Vl, L, w + 4, slope2d, qpos, 0, dhi, B0);
    }
    const float lt = half_sum(st.l);
    if (kind == 0) {
        const float sink2 = in_ptr(7)[layer * 8 + hq] * LOG2E;
        const float mf = fmaxf(st.m, sink2), sc = fexp2(st.m - mf), lf = lt * sc + fexp2(sink2 - mf);
        store_o_bf16((bf16_t*)(ws + WS_OCAT) + (size_t)t * KCAT + 512 + 64 * hq, st, sc / lf, L.hi);
    } else {
        store_o_bf16((bf16_t*)(ws + WS_CSCR) + ((size_t)(g * S + t) * 4 + cc) * 64, st, 1.0f / lt, L.hi);
        if (L.hi == 0) ((float*)(ws + WS_CLSE))[(size_t)(g * S + t) * 4 + cc] = st.m + __log2f(lt);
    }
}
__device__ __forceinline__ void att_unit_moba_part(LAS unsigned char* lds, const Ctx& c, unsigned char* ws, int Lid, int ti) {
    const bf16_t* zq = (const bf16_t*)(ws + WS_ZQ);
    const int h = Lid >> 6, j = Lid & 63;
    LAS unsigned char* Kl = lds + ATT_K_OFF; LAS unsigned char* Vl = lds + ATT_V_OFF;
    __syncthreads();
    stage_rows<0>(Kl, zq, A_K + 64 * h, 256 * j, 1, 256, c.tid); stage_rows<1>(Vl, zq, A_V + 64 * h, 256 * j, 1, 256, c.tid);
    __syncthreads();
    const int n = (int)((const unsigned*)(ws + WS_CNT))[Lid];
    const int e0 = ti * 256 + 32 * c.wave;
    if (e0 >= n) return;
    const AttLane L = att_lane(c.lane);
    const int e = e0 + L.r32; const bool valid = e < n;
    const unsigned ent = ((const unsigned short*)(ws + WS_U))[(size_t)Lid * 16384 + (valid ? e : n - 1)];
    const int t = (int)(ent & 0x3fffu), slot = (int)(ent >> 14), qpos = t - 256 * j;
    bf16x8 qf[4]; load_qf(qf, zq + (size_t)t * NQKV + A_Q + 64 * h, L.hi);
    const float slope2d = alibi_slope(20 + h) * LOG2E;
    QState st; f32x16 B0; att_init(st, B0, slope2d, L.hi);
#pragma unroll 1
    for (int kt = 0; kt < 8; ++kt) att_tile<false>(st, qf, Kl, Vl, L, kt, slope2d, qpos, 0, 0, B0);
    const float lt = half_sum(st.l);
    if (valid) {
        float* pp = (float*)(ws + WS_PART) + ((size_t)(t * 8 + h) * 3 + slot) * 64;
#pragma unroll
        for (int g4 = 0; g4 < 4; ++g4) { *(GAS f32x4*)(pp + 8 * g4 + 4 * L.hi) = (f32x4){st.o0[4 * g4], st.o0[4 * g4 + 1], st.o0[4 * g4 + 2], st.o0[4 * g4 + 3]};
            *(GAS f32x4*)(pp + 32 + 8 * g4 + 4 * L.hi) = (f32x4){st.o1[4 * g4], st.o1[4 * g4 + 1], st.o1[4 * g4 + 2], st.o1[4 * g4 + 3]}; }
        if (L.hi == 0) *(GAS f32x2*)((float*)(ws + WS_PARTML) + ((size_t)(t * 8 + h) * 3 + slot) * 2) = (f32x2){st.m, lt};
    }
}
__device__ __forceinline__ void att_unit_moba_own(LAS unsigned char* lds, const Ctx& c, unsigned char* ws, int h, int b) {
    const bf16_t* zq = (const bf16_t*)(ws + WS_ZQ);
    LAS unsigned char* Kl = lds + ATT_K_OFF; LAS unsigned char* Vl = lds + ATT_V_OFF;
    __syncthreads();
    stage_rows<0>(Kl, zq, A_K + 64 * h, 256 * b, 1, 256, c.tid); stage_rows<1>(Vl, zq, A_V + 64 * h, 256 * b, 1, 256, c.tid);
    __syncthreads();
    const AttLane L = att_lane(c.lane);
    const int w = c.wave, qi = 32 * w + L.r32, t = 256 * b + qi;
    bf16x8 qf[4]; load_qf(qf, zq + (size_t)t * NQKV + A_Q + 64 * h, L.hi);
    const float slope2d = alibi_slope(20 + h) * LOG2E;
    QState st; f32x16 B0; att_init(st, B0, slope2d, L.hi);
#pragma unroll 1
    for (int kt = 0; kt < w; ++kt) att_tile<false>(st, qf, Kl, Vl, L, kt, slope2d, qi, 0, 0, B0);
    att_tile<true>(st, qf, Kl, Vl, L, w, slope2d, qi, 0, 1 << 30, B0);
    float lt = half_sum(st.l);
    const int nv = b < 3 ? b : 3;
    const float* pml = (const float*)(ws + WS_PARTML) + (size_t)(t * 8 + h) * 6;
    const float* pp = (const float*)(ws + WS_PART) + (size_t)(t * 8 + h) * 192;
    float ms[3], ls[3]; float mt = st.m;
#pragma unroll
    for (int s = 0; s < 3; ++s) { ms[s] = -1e30f; ls[s] = 0.f; if (s < nv) { const f32x2 v = *(const GAS f32x2*)(pml + 2 * s); ms[s] = v[0]; ls[s] = v[1]; mt = fmaxf(mt, ms[s]); } }
    const float a0 = fexp2(st.m - mt); lt *= a0; st.o0 = st.o0 * a0; st.o1 = st.o1 * a0;
#pragma unroll
    for (int s = 0; s < 3; ++s) if (s < nv) { const float as = fexp2(ms[s] - mt); lt += ls[s] * as;
#pragma unroll
        for (int g4 = 0; g4 < 4; ++g4) { const f32x4 x0 = *(const GAS f32x4*)(pp + 64 * s + 8 * g4 + 4 * L.hi), x1 = *(const GAS f32x4*)(pp + 64 * s + 32 + 8 * g4 + 4 * L.hi);
#pragma unroll
            for (int i = 0; i < 4; ++i) { st.o0[4 * g4 + i] += as * x0[i]; st.o1[4 * g4 + i] += as * x1[i]; } } }
    store_o_bf16((bf16_t*)(ws + WS_OCAT) + (size_t)t * KCAT + 64 * h, st, 1.0f / lt, L.hi);
}
__device__ __forceinline__ void ph_att1(LAS unsigned char* lds, int layer) {
    const Ctx c = make_ctx(); unsigned char* ws = ws_ptr();
    LAS unsigned* pre = (LAS unsigned*)(lds + ATT_MISC_OFF);
    LAS unsigned* wsum = pre + 520;
    { unsigned v = (((const unsigned*)(ws + WS_CNT))[c.tid] + 255u) >> 8;
#pragma unroll
      for (int o = 1; o < 64; o <<= 1) { const unsigned t2 = __shfl_up(v, o); if (c.lane >= o) v += t2; }
      if (c.lane == 63) wsum[c.wave] = v;
      __syncthreads();
      unsigned off = 0; for (int w2 = 0; w2 < c.wave; ++w2) off += wsum[w2];
      pre[c.tid + 1] = v + off; if (c.tid == 0) pre[0] = 0u;
      __syncthreads(); }
    const int total = (int)pre[512];
    for (int u = c.vcu; u < total + 1280; u += c.G) {
        if (u < total) { int lo = 0, hi = 512; while (hi - lo > 1) { const int mid = (lo + hi) >> 1; if ((int)pre[mid] <= u) lo = mid; else hi = mid; }
            att_unit_moba_part(lds, c, ws, lo, u - (int)pre[lo]); }
        else att_unit_windowed(lds, c, ws, u - total, layer);
    }
}
__device__ __forceinline__ void ph_att2(LAS unsigned char* lds) {
    const Ctx c = make_ctx(); unsigned char* ws = ws_ptr();
    for (int u = c.vcu; u < 512; u += c.G) att_unit_moba_own(lds, c, ws, u >> 6, u & 63);
}

__device__ __forceinline__ void ph_adaln_convert0(LAS unsigned char* lds) {
    const Ctx c = make_ctx(); unsigned char* ws = ws_ptr();
    const float* cvec = in_ptr(1); const float* w_ada = in_ptr(2); const float* b_ada = in_ptr(3);
    float* mod = (float*)(ws + WS_MOD);
    LAS float* red = (LAS float*)lds;
    for (int unit = c.vcu; unit < DEPTH * 96; unit += c.G) {
        const int l = unit / 96, n0 = (unit % 96) * 64;
        const float* W = w_ada + (size_t)l * D * 6 * D + n0 + c.lane;
        float a = 0.f;
#pragma unroll 8
        for (int k = c.wave * 128; k < c.wave * 128 + 128; ++k) { const float cv = cvec[k]; const float sl = cv * frcp(1.0f + __expf(-cv)); a += sl * W[(size_t)k * (6 * D)]; }
        red[c.wave * 64 + c.lane] = a;
        __syncthreads();
        if (c.wave == 0) { float s = 0.f;
#pragma unroll
            for (int w = 0; w < 8; ++w) s += red[w * 64 + c.lane];
            mod[((size_t)l * 12 + 6) * D + n0 + c.lane] = s + b_ada[(size_t)l * 6 * D + n0 + c.lane]; }
        __syncthreads();
    }
}
__device__ __forceinline__ void ph_convert(LAS unsigned char* lds, int n, int which, int wg0, int nwg) {
    const Ctx c = make_ctx(); unsigned char* ws = ws_ptr();
    if (c.bx < wg0 || c.bx >= wg0 + nwg) return;
    LAS float* scr = (LAS float*)(lds + c.wave * 16384);
    const int gw = (c.bx - wg0) * NWAVES + c.wave, ngw = nwg * NWAVES;
    int first = 0;
    if (which & 1) convert_matrix(in_ptr(6) + (size_t)n * D * NIN, D, NIN, (bf16_t*)(ws + WS_WIN), D, 0, 0, scr, gw, ngw, c.lane, first);
    if (which & 2) {
        convert_matrix(in_ptr(8) + (size_t)n * 512 * D, 512, D, (bf16_t*)(ws + WS_WCAT), KCAT, 0, 0, scr, gw, ngw, c.lane, first);
        convert_matrix(in_ptr(9) + (size_t)n * 512 * D, 512, D, (bf16_t*)(ws + WS_WCAT), KCAT, 512, 0, scr, gw, ngw, c.lane, first);
        convert_matrix(in_ptr(10) + (size_t)n * 256 * D, 256, D, (bf16_t*)(ws + WS_WCAT), KCAT, 1024, 0, scr, gw, ngw, c.lane, first);
        convert_matrix(in_ptr(11) + (size_t)n * D * D, D, D, (bf16_t*)(ws + WS_WOUT), D, 0, 0, scr, gw, ngw, c.lane, first);
    }
    if (which & 4) {
        convert_matrix(in_ptr(14) + (size_t)n * D * DFF, D, DFF, (bf16_t*)(ws + WS_WGU), D, 0, 1, scr, gw, ngw, c.lane, first);
        convert_matrix(in_ptr(15) + (size_t)n * D * DFF, D, DFF, (bf16_t*)(ws + WS_WGU), D, 0, 2, scr, gw, ngw, c.lane, first);
        convert_matrix(in_ptr(16) + (size_t)n * DFF * D, DFF, D, (bf16_t*)(ws + WS_WDN), DFF, 0, 0, scr, gw, ngw, c.lane, first);
    }
}
__device__ __forceinline__ void ph_modtables() {
    const Ctx c = make_ctx(); unsigned char* ws = ws_ptr();
    float* mod = (float*)(ws + WS_MOD);
    const float* g_pre_mix = in_ptr(4); const float* g_post_mix = in_ptr(5); const float* g_pre_ffn = in_ptr(12); const float* g_post_ffn = in_ptr(13);
    for (int i = c.bx * NTHREADS + c.tid; i < DEPTH * D; i += c.G * NTHREADS) {
        const int l = i / D, n = i % D; float* m = mod + (size_t)l * 12 * D;
        const float sh1 = m[6 * D + n], sc1 = m[7 * D + n], gt1 = m[8 * D + n], sh2 = m[9 * D + n], sc2 = m[10 * D + n], gt2 = m[11 * D + n];
        m[0 * D + n] = g_pre_mix[l * D + n] * (1.0f + sc1); m[1 * D + n] = sh1; m[2 * D + n] = gt1 * g_post_mix[l * D + n];
        m[3 * D + n] = g_pre_ffn[l * D + n] * (1.0f + sc2); m[4 * D + n] = sh2; m[5 * D + n] = gt2 * g_post_ffn[l * D + n];
    }
}
__device__ __forceinline__ void ph_norm(int kind, int l) {
    const Ctx c = make_ctx(); unsigned char* ws = ws_ptr();
    const float* mod = (const float*)(ws + WS_MOD); const float* modl = mod + (size_t)l * 12 * D;
    bf16_t* ub = (bf16_t*)(ws + WS_U); float* out = out_ptr();
    if (kind == 0) norm_rows(nullptr, in_ptr(0), nullptr, nullptr, mod + 0 * D, mod + 1 * D, ub, c.gw, c.ngw, c.lane);
    else if (kind == 1) norm_rows((const float*)(ws + WS_Y), l == 0 ? in_ptr(0) : out, out, modl + 2 * D, modl + 3 * D, modl + 4 * D, ub, c.gw, c.ngw, c.lane);
    else norm_rows((const float*)(ws + WS_Y2), out, out, modl + 5 * D, modl + 12 * D, modl + 13 * D, (l + 1 < DEPTH) ? ub : nullptr, c.gw, c.ngw, c.lane);
}
__device__ __forceinline__ void ph_inproj(LAS unsigned char* lds) {
    const Ctx c = make_ctx(); unsigned char* ws = ws_ptr();
    pg8::Gemm g{(const bf16_t*)(ws + WS_U), (const bf16_t*)(ws + WS_WIN), D, D}; pg8::StaticOrder So; So.init(S, NIN, D, c.G, c.bx);
    pg8::EpiInproj E{(bf16_t*)(ws + WS_ZQ), (bf16_t*)(ws + WS_GATES)};
    pg8::gemm_phase<pg8::EpiInproj, pg8::StaticOrder, true>(lds, g, So, E);
}
__device__ __forceinline__ void ph_merge(LAS unsigned char* lds) {
    const Ctx c = make_ctx(); unsigned char* ws = ws_ptr();
    pg8::Gemm g{(const bf16_t*)(ws + WS_OCAT), (const bf16_t*)(ws + WS_WCAT), KCAT, KCAT}; pg8::MergeOrder So; So.init(S, D, c.G, c.bx);
    pg8::EpiMerge E{(const bf16_t*)(ws + WS_GATES), (float*)(ws + WS_MSCR), (bf16_t*)(ws + WS_MERGED)};
    pg8::gemm_phase<pg8::EpiMerge, pg8::MergeOrder, false>(lds, g, So, E);
}
__device__ __forceinline__ void ph_wout(LAS unsigned char* lds) {
    const Ctx c = make_ctx(); unsigned char* ws = ws_ptr();
    pg8::Gemm g{(const bf16_t*)(ws + WS_MERGED), (const bf16_t*)(ws + WS_WOUT), D, D}; pg8::StaticOrder So; So.init(S, D, D, c.G, c.bx);
    pg8::EpiF32 E{(float*)(ws + WS_Y), D};
    pg8::gemm_phase<pg8::EpiF32, pg8::StaticOrder, false>(lds, g, So, E);
}
__device__ __forceinline__ void ph_gateup(LAS unsigned char* lds) {
    const Ctx c = make_ctx(); unsigned char* ws = ws_ptr();
    pg8::Gemm g{(const bf16_t*)(ws + WS_U), (const bf16_t*)(ws + WS_WGU), D, D}; pg8::StaticOrder So; So.init(S, NGU, D, c.G, c.bx);
    pg8::EpiSwiglu E{(bf16_t*)(ws + WS_ACT)};
    pg8::gemm_phase<pg8::EpiSwiglu, pg8::StaticOrder, true>(lds, g, So, E);
}
__device__ __forceinline__ void ph_down(LAS unsigned char* lds) {
    const Ctx c = make_ctx(); unsigned char* ws = ws_ptr();
    pg8::Gemm g{(const bf16_t*)(ws + WS_ACT), (const bf16_t*)(ws + WS_WDN), DFF, DFF}; pg8::StaticOrder So; So.init(S, D, DFF, c.G, c.bx);
    pg8::EpiF32 E{(float*)(ws + WS_Y2), D};
    pg8::gemm_phase<pg8::EpiF32, pg8::StaticOrder, false>(lds, g, So, E);
}
__device__ __forceinline__ void ph_kmean() {
    const Ctx c = make_ctx(); unsigned char* ws = ws_ptr();
    unsigned* cnt = (unsigned*)(ws + WS_CNT); float* kmean = (float*)(ws + WS_KMEAN); const bf16_t* zq = (const bf16_t*)(ws + WS_ZQ);
    if (c.bx == 0) cnt[c.tid] = 0u;
    for (int item = c.gw; item < 512; item += c.ngw) {
        const int h = item >> 6, j = item & 63;
        const bf16_t* kp = zq + (size_t)(256 * j + (c.lane >> 3)) * NQKV + A_K + 64 * h + 8 * (c.lane & 7);
        float a[8];
#pragma unroll
        for (int i = 0; i < 8; ++i) a[i] = 0.f;
        for (int p = 0; p < 32; ++p) { const u32x4 w = *(const GAS u32x4*)(kp + (size_t)(8 * p) * NQKV);
            a[0] += bflo(w.x); a[1] += bfhi(w.x); a[2] += bflo(w.y); a[3] += bfhi(w.y); a[4] += bflo(w.z); a[5] += bfhi(w.z); a[6] += bflo(w.w); a[7] += bfhi(w.w); }
#pragma unroll
        for (int i = 0; i < 8; ++i) { a[i] += __shfl_xor(a[i], 8); a[i] += __shfl_xor(a[i], 16); a[i] += __shfl_xor(a[i], 32); }
        if (c.lane < 8) {
#pragma unroll
            for (int i = 0; i < 8; ++i) kmean[(size_t)item * 64 + 8 * c.lane + i] = a[i] * (1.0f / 256.0f);
        }
    }
}
__device__ __forceinline__ void ph_topk(LAS unsigned char* lds) {
    const Ctx c = make_ctx(); unsigned char* ws = ws_ptr();
    const float* kmean = (const float*)(ws + WS_KMEAN); const bf16_t* zq = (const bf16_t*)(ws + WS_ZQ); unsigned char* sel = ws + WS_SEL;
    LAS float* km = (LAS float*)lds;
    LAS unsigned* lcnt = (LAS unsigned*)(lds + 16384); LAS unsigned* lbase = lcnt + 64;
    for (int item = c.vcu; item < 256; item += c.G) {
        const int h = item >> 5, t = (item & 31) * 512 + c.tid, b = t >> 8;
        __syncthreads();
        for (int i = c.tid; i < 4096; i += NTHREADS) km[i] = kmean[(size_t)h * 4096 + i];
        if (c.tid < 64) lcnt[c.tid] = 0u;
        __syncthreads();
        float q[64]; load_row64(zq + (size_t)t * NQKV + A_Q + 64 * h, q);
        float v1 = -INFINITY, v2 = -INFINITY, v3 = -INFINITY; int i1 = 0, i2 = 0, i3 = 0;
        for (int j = 0; j < b; ++j) {
            float g0 = 0.f, g1 = 0.f;
#pragma unroll
            for (int d = 0; d < 64; d += 4) { const f32x4 kv = *(const LAS f32x4*)(km + j * 64 + d); g0 += q[d] * kv[0]; g1 += q[d + 1] * kv[1]; g0 += q[d + 2] * kv[2]; g1 += q[d + 3] * kv[3]; }
            const float gsc = g0 + g1;
            const bool c1 = gsc > v1, c2 = gsc > v2, c3 = gsc > v3;
            v3 = c2 ? v2 : (c3 ? gsc : v3); i3 = c2 ? i2 : (c3 ? j : i3);
            v2 = c1 ? v1 : (c2 ? gsc : v2); i2 = c1 ? i1 : (c2 ? j : i2);
            v1 = c1 ? gsc : v1;             i1 = c1 ? j : i1;
        }
        const int nv = b < 3 ? b : 3;
        *(GAS unsigned*)(sel + ((size_t)t * 8 + h) * 4) = (unsigned)i1 | ((unsigned)i2 << 8) | ((unsigned)i3 << 16) | ((unsigned)nv << 24);
        { unsigned* cnt = (unsigned*)(ws + WS_CNT); unsigned short* lists = (unsigned short*)(ws + WS_U);
          const int is[3] = {i1, i2, i3}; unsigned lp[3];
#pragma unroll
          for (int s = 0; s < 3; ++s) lp[s] = (s < nv) ? atomicAdd((unsigned*)&lcnt[is[s]], 1u) : 0u;
          __syncthreads();
          if (c.tid < 64) { const unsigned n = lcnt[c.tid]; lbase[c.tid] = n ? atomicAdd(&cnt[h * 64 + c.tid], n) : 0u; }
          __syncthreads();
#pragma unroll
          for (int s = 0; s < 3; ++s) if (s < nv) { const int Lid = h * 64 + is[s]; lists[(size_t)Lid * 16384 + lbase[is[s]] + lp[s]] = (unsigned short)(t | (s << 14)); } }
    }
}
__device__ __forceinline__ void ph_att_scalar_moba() {
    const Ctx c = make_ctx(); unsigned char* ws = ws_ptr();
    const bf16_t* zq = (const bf16_t*)(ws + WS_ZQ); bf16_t* ocat = (bf16_t*)(ws + WS_OCAT); const unsigned char* sel = ws + WS_SEL;
    for (int item = c.vcu; item < 256; item += c.G) {
        const int h = item >> 5, t = (item & 31) * 512 + c.tid, b = t >> 8;
        const float sl2 = alibi_slope(20 + h) * LOG2E;
        float q[64]; load_row64(zq + (size_t)t * NQKV + A_Q + 64 * h, q);
        SAcc a; a.m = -1e30f; a.l = 0.f;
#pragma unroll
        for (int d = 0; d < 64; ++d) a.o[d] = 0.f;
        const unsigned sw = *(const GAS unsigned*)(sel + ((size_t)t * 8 + h) * 4); const int nv = (int)(sw >> 24);
        for (int s = 0; s < nv; ++s) { const int j = (int)((sw >> (8 * s)) & 0xffu);
            for (int k = 0; k < 256; ++k) { const int tk = 256 * j + k; const bf16_t* rp = zq + (size_t)tk * NQKV + 64 * h;
                attend_key(a, q, rp + A_K, rp + A_V, -sl2 * (float)(t - tk)); } }
        for (int tk = 256 * b; tk <= t; ++tk) { const bf16_t* rp = zq + (size_t)tk * NQKV + 64 * h; attend_key(a, q, rp + A_K, rp + A_V, -sl2 * (float)(t - tk)); }
        store_row64_bf16(ocat + (size_t)t * KCAT + 64 * h, a.o, 1.0f / a.l);
    }
}
__device__ __forceinline__ void ph_att_scalar_swa(int l) {
    const Ctx c = make_ctx(); unsigned char* ws = ws_ptr();
    const bf16_t* zq = (const bf16_t*)(ws + WS_ZQ); bf16_t* ocat = (bf16_t*)(ws + WS_OCAT); const float* sinks = in_ptr(7);
    for (int item = c.vcu; item < 256; item += c.G) {
        const int hq = item >> 5, t = (item & 31) * 512 + c.tid, g = hq >> 2;
        const float sl2 = alibi_slope(hq) * LOG2E;
        float q[64]; load_row64(zq + (size_t)t * NQKV + B_Q + 64 * hq, q);
        SAcc a; a.m = sinks[l * 8 + hq] * LOG2E; a.l = 1.f;
#pragma unroll
        for (int d = 0; d < 64; ++d) a.o[d] = 0.f;
        const int t0 = t - 127 < 0 ? 0 : t - 127;
        for (int tk = t0; tk <= t; ++tk) { const bf16_t* rp = zq + (size_t)tk * NQKV + 64 * g; attend_key(a, q, rp + B_K, rp + B_V, -sl2 * (float)(t - tk)); }
        store_row64_bf16(ocat + (size_t)t * KCAT + 512 + 64 * hq, a.o, 1.0f / a.l);
    }
}
__device__ __forceinline__ void ph_att_scalar_dil() {
    const Ctx c = make_ctx(); unsigned char* ws = ws_ptr();
    const bf16_t* zq = (const bf16_t*)(ws + WS_ZQ); bf16_t* cscr = (bf16_t*)(ws + WS_CSCR); float* clse = (float*)(ws + WS_CLSE);
    for (int item = c.vcu; item < 384; item += c.G) {
        const int gc = item >> 5, g = gc >> 2, cc = gc & 3, t = (item & 31) * 512 + c.tid, dil = g == 0 ? 1 : (g == 1 ? 4 : 16);
        const float sl2 = alibi_slope(8 + gc) * LOG2E;
        const int qc = C_BASE + 768 * g + 64 * cc;
        float q[64]; load_row64(zq + (size_t)t * NQKV + qc, q);
        SAcc a; a.m = -1e30f; a.l = 0.f;
#pragma unroll
        for (int d = 0; d < 64; ++d) a.o[d] = 0.f;
        for (int s = 0; s <= 128; ++s) { const int tk = t - dil * s; if (tk < 0) break; const bf16_t* rp = zq + (size_t)tk * NQKV + qc; attend_key(a, q, rp + 256, rp + 512, -sl2 * (float)(dil * s)); }
        store_row64_bf16(cscr + ((size_t)(g * S + t) * 4 + cc) * 64, a.o, 1.0f / a.l);
        clse[(size_t)(g * S + t) * 4 + cc] = a.m + __log2f(a.l);
    }
}
__device__ __forceinline__ void ph_dil_combine() {
    const Ctx c = make_ctx(); unsigned char* ws = ws_ptr();
    const bf16_t* cscr = (const bf16_t*)(ws + WS_CSCR); const float* clse = (const float*)(ws + WS_CLSE); bf16_t* ocat = (bf16_t*)(ws + WS_OCAT);
    for (int i = c.bx * NTHREADS + c.tid; i < S * 4 * 16; i += c.G * NTHREADS) {
        const int t = i >> 6, cc = (i >> 4) & 3, d4 = (i & 15) * 4;
        const float l0 = clse[(size_t)(0 * S + t) * 4 + cc], l1 = clse[(size_t)(1 * S + t) * 4 + cc], l2 = clse[(size_t)(2 * S + t) * 4 + cc];
        const float mx = fmaxf(l0, fmaxf(l1, l2)); const float e0 = fexp2(l0 - mx), e1 = fexp2(l1 - mx), e2 = fexp2(l2 - mx), inv = 1.0f / (e0 + e1 + e2);
        const u32x2 w0 = *(const GAS u32x2*)(cscr + ((size_t)(0 * S + t) * 4 + cc) * 64 + d4), w1 = *(const GAS u32x2*)(cscr + ((size_t)(1 * S + t) * 4 + cc) * 64 + d4), w2 = *(const GAS u32x2*)(cscr + ((size_t)(2 * S + t) * 4 + cc) * 64 + d4);
        const f32x4 o0 = (f32x4){bflo(w0.x), bfhi(w0.x), bflo(w0.y), bfhi(w0.y)}, o1 = (f32x4){bflo(w1.x), bfhi(w1.x), bflo(w1.y), bfhi(w1.y)}, o2 = (f32x4){bflo(w2.x), bfhi(w2.x), bflo(w2.y), bfhi(w2.y)};
        const f32x4 o = (o0 * e0 + o1 * e1 + o2 * e2) * inv;
        u32x2 w; w.x = pk2(o[0], o[1]); w.y = pk2(o[2], o[3]);
        *(GAS u32x2*)(ocat + (size_t)t * KCAT + 1024 + 64 * cc + d4) = w;
    }
}

struct Args { const float* in[17]; float* out; unsigned char* ws; int ph_lo, ph_hi; };
__global__ void __launch_bounds__(NTHREADS, 2) trunk_fwd(Args args) {
    extern __shared__ __attribute__((aligned(16))) unsigned char lds_raw[];
    LAS unsigned char* lds = (LAS unsigned char*)lds_raw;
    volatile LAS unsigned* MISC = (volatile LAS unsigned*)(lds + MISC_OFF);
    if (threadIdx.x < 64) MISC[threadIdx.x] = 0u;
    __syncthreads();
    XcdBarrier bar; bar.bar = (unsigned*)(args.ws + WS_CTL); bar.x = 0; bar.st = nullptr;
#if !MK_MULTI
    bar = xcd_barrier_post((unsigned*)(args.ws + WS_CTL), MISC + 8);
#endif
    const int lo = args.ph_lo, hi = args.ph_hi;
    int step = 0;
#define PHASE_BEGIN if (step >= lo && step < hi) {
#if MK_MULTI
#define PHASE_END } ++step;
#else
#define PHASE_END if (step + 1 < hi) xcd_barrier(bar); } ++step;
#endif
    PHASE_BEGIN ph_adaln_convert0(lds); ph_convert(lds, 0, 3, 0, (int)gridDim.x); PHASE_END
    PHASE_BEGIN ph_modtables(); PHASE_END
    PHASE_BEGIN ph_norm(0, 0); PHASE_END
    for (int l = 0; l < DEPTH; ++l) {
        PHASE_BEGIN ph_inproj(lds); if (DUP_MASK & 1) ph_inproj(lds); { const int G_ = (int)gridDim.x, r_ = (S / 256) * (NIN / 256) % G_; if (r_) ph_convert(lds, l, 4, r_, G_ - r_); else ph_convert(lds, l, 4, 0, G_); } PHASE_END
        PHASE_BEGIN ph_kmean(); PHASE_END
        PHASE_BEGIN ph_topk(lds); PHASE_END
#if ATT_SCALAR
        PHASE_BEGIN ph_att_scalar_moba(); ph_att_scalar_swa(l); ph_att_scalar_dil(); PHASE_END
        PHASE_BEGIN ph_dil_combine(); PHASE_END
#else
        PHASE_BEGIN ph_att1(lds, l); if (DUP_MASK & 4) ph_att1(lds, l); PHASE_END
        PHASE_BEGIN ph_att2(lds); ph_dil_combine(); if (DUP_MASK & 8) { ph_att2(lds); ph_dil_combine(); } PHASE_END
#endif
        PHASE_BEGIN ph_merge(lds); if (DUP_MASK & 16) ph_merge(lds); PHASE_END
        PHASE_BEGIN ph_wout(lds); if (DUP_MASK & 32) ph_wout(lds); PHASE_END
        PHASE_BEGIN ph_norm(1, l); PHASE_END
        PHASE_BEGIN ph_gateup(lds); if (DUP_MASK & 64) ph_gateup(lds); if (l + 1 < DEPTH) { const int G_ = (int)gridDim.x, r_ = (S / 256) * (NGU / 256) % G_; if (r_) ph_convert(lds, l + 1, 3, r_, G_ - r_); else ph_convert(lds, l + 1, 3, 0, G_); } PHASE_END
        PHASE_BEGIN ph_down(lds); if (DUP_MASK & 128) ph_down(lds); PHASE_END
        PHASE_BEGIN ph_norm(2, l); PHASE_END
    }
#undef PHASE_BEGIN
#undef PHASE_END
}
constexpr int N_STEPS = 3 + DEPTH * 11;

extern "C" void kernel_launch(void* const* d_in, const int* in_sizes, int n_in, void* d_out, int out_size, void* d_ws, size_t ws_size, hipStream_t stream) {
    static int grid = 0;
    if (grid == 0) {
        if (n_in != 17 || in_sizes[0] != S * D || out_size != S * D || ws_size < WS_END) { fprintf(stderr, "kernel_launch: unexpected shapes / workspace (%d inputs, ws %zu)\n", n_in, ws_size); grid = -1; return; }
        int dev = 0, cus = 0, per_cu = 0;
        if (hipGetDevice(&dev) != hipSuccess || hipDeviceGetAttribute(&cus, hipDeviceAttributeMultiprocessorCount, dev) != hipSuccess) { grid = -1; return; }
        if (hipFuncSetAttribute((const void*)trunk_fwd, hipFuncAttributeMaxDynamicSharedMemorySize, LDS_BYTES) != hipSuccess) { grid = -1; return; }
        if (hipOccupancyMaxActiveBlocksPerMultiprocessor(&per_cu, (const void*)trunk_fwd, NTHREADS, LDS_BYTES) != hipSuccess || per_cu < 1) { fprintf(stderr, "kernel_launch: occupancy query says %d\n", per_cu); }
        (void)hipGetLastError();
        grid = cus;
    }
    if (grid < 0) return;
    (void)hipMemsetAsync((char*)d_ws + WS_CTL, 0, CTL_ZERO_BYTES, stream);
    Args a{};
    for (int i = 0; i < 17; ++i) a.in[i] = (const float*)d_in[i];
    a.out = (float*)d_out; a.ws = (unsigned char*)d_ws;
#if MK_MULTI
#ifndef MK_MAX_STEP
#define MK_MAX_STEP N_STEPS
#endif
    for (int s = 0; s < MK_MAX_STEP; ++s) { a.ph_lo = s; a.ph_hi = s + 1; hipLaunchKernelGGL(trunk_fwd, dim3(grid), dim3(NTHREADS), LDS_BYTES, stream, a); }
#else
    a.ph_lo = 0; a.ph_hi = N_STEPS; hipLaunchKernelGGL(trunk_fwd, dim3(grid), dim3(NTHREADS), LDS_BYTES, stream, a);
#endif
}
```
